# Optimizing an MI355X kernel written in HIP

```python
import jax, jax.numpy as jnp
from jax import lax
import numpy as np

D_MODEL = 1024
BATCH = 2
SEQ = 8192
DEPTH = 2

N_MIXERS = 2
N_META = 16
BLOCK = 128
N_PAD = BLOCK - N_META
RMS_EPS = 1e-6

A_HEADS = 16
A_KV_HEADS = 2
A_HEAD_DIM = 64
A_GROUP = A_HEADS // A_KV_HEADS
A_WIDTH = A_HEADS * A_HEAD_DIM
A_KV_WIDTH = A_KV_HEADS * A_HEAD_DIM
A_IN = 2 * A_WIDTH + 2 * A_KV_WIDTH
WINDOW = 128
ROPE_THETA = 10000.0

B_HEADS = 8
B_QK_DIM = 64
B_V_DIM = 128
B_QK_WIDTH = B_HEADS * B_QK_DIM
B_WIDTH = B_HEADS * B_V_DIM
B_IN = 2 * B_QK_WIDTH + 3 * B_WIDTH + 2 * B_HEADS

N_LAYERS_A = (DEPTH + 1) // 2
N_LAYERS_B = DEPTH // 2

kernel_name = "hybrid_swa_sink_mlstm_interleaved"


def rmsnorm(x, g):
    xf = x.astype(jnp.float32)
    y = xf * lax.rsqrt(jnp.mean(xf * xf, axis=-1, keepdims=True) + RMS_EPS)
    return (y * g.astype(jnp.float32)).astype(x.dtype)


def rope(t, pos):
    half = t.shape[-1] // 2
    inv = ROPE_THETA ** (-jnp.arange(half, dtype=jnp.float32) / half)
    ang = pos.astype(jnp.float32)[:, None] * inv[None, :]
    cos = jnp.cos(ang)[None, :, None, :]
    sin = jnp.sin(ang)[None, :, None, :]
    t1 = t[..., :half].astype(jnp.float32)
    t2 = t[..., half:].astype(jnp.float32)
    out = jnp.concatenate([t1 * cos - t2 * sin, t2 * cos + t1 * sin], axis=-1)
    return out.astype(t.dtype)


def swa_sink_mixer(u, w_in, sinks, pos, valid):
    bsz, L, _ = u.shape
    nb = L // BLOCK
    proj = u @ w_in
    q, k, v, z = jnp.split(proj, [A_WIDTH, A_WIDTH + A_KV_WIDTH, A_WIDTH + 2 * A_KV_WIDTH], axis=-1)
    q = rope(q.reshape(bsz, L, A_HEADS, A_HEAD_DIM), pos)
    k = rope(k.reshape(bsz, L, A_KV_HEADS, A_HEAD_DIM), pos)
    v = v.reshape(bsz, L, A_KV_HEADS, A_HEAD_DIM)
    qb = q.reshape(bsz, nb, BLOCK, A_KV_HEADS, A_GROUP, A_HEAD_DIM)

    def with_prev(t):
        tb = t.reshape(bsz, nb, BLOCK, A_KV_HEADS, A_HEAD_DIM)
        prev = jnp.pad(tb[:, :-1], ((0, 0), (1, 0), (0, 0), (0, 0), (0, 0)))
        return jnp.concatenate([prev, tb], axis=2)

    kb, vb = with_prev(k), with_prev(v)
    s = jnp.einsum('bntkgd,bnskd->bnkgts', qb, kb,
                   preferred_element_type=jnp.float32) * (A_HEAD_DIM ** -0.5)

    dist = (jnp.arange(BLOCK)[:, None] + BLOCK) - jnp.arange(2 * BLOCK)[None, :]
    band = (dist >= 0) & (dist < WINDOW)
    vblk = valid.reshape(nb, BLOCK)
    vprev = jnp.concatenate([jnp.zeros((1, BLOCK), dtype=bool), vblk[:-1]], axis=0)
    key_valid = jnp.concatenate([vprev, vblk], axis=-1)
    mask = band[None] & key_valid[:, None, :]
    s = jnp.where(mask[None, :, None, None], s, -jnp.inf)

    sink = sinks.astype(jnp.float32).reshape(A_KV_HEADS, A_GROUP)[None, None, :, :, None, None]
    m = jnp.maximum(s.max(axis=-1, keepdims=True), sink)
    p = jnp.exp(s - m)
    p = p / (p.sum(axis=-1, keepdims=True) + jnp.exp(sink - m))
    o = jnp.einsum('bnkgts,bnskd->bntkgd', p.astype(vb.dtype), vb)
    o = o.reshape(bsz, L, A_WIDTH)
    return o * jax.nn.silu(z)


def mlstm_mixer(u, w_in, b_gates, valid):
    f32 = jnp.float32
    bsz, L, _ = u.shape
    nc = L // BLOCK
    proj = u @ w_in
    cuts = np.cumsum([B_QK_WIDTH, B_QK_WIDTH, B_WIDTH, B_WIDTH, B_WIDTH]).tolist()
    q, k, v, o_pre, z, gates = jnp.split(proj, cuts, axis=-1)
    gates = gates.astype(f32) + b_gates.astype(f32)
    vmask = valid[None, :, None]
    log_f = jnp.where(vmask, jax.nn.log_sigmoid(gates[..., B_HEADS:]), 0.0)
    i_log = jnp.where(vmask, gates[..., :B_HEADS], -jnp.inf)

    def chunk_gate(g):
        return g.reshape(bsz, nc, BLOCK, B_HEADS).transpose(0, 3, 1, 2)

    def heads(t, d):
        return t.reshape(bsz, nc, BLOCK, B_HEADS, d).transpose(0, 3, 1, 2, 4).astype(f32)

    log_f, i_log = chunk_gate(log_f), chunk_gate(i_log)
    qh = heads(q, B_QK_DIM)
    kh = heads(k, B_QK_DIM) * (B_QK_DIM ** -0.5)
    vh = heads(v, B_V_DIM)

    b = jnp.cumsum(log_f, axis=-1)
    g = b[..., -1]

    a = g[..., None] - b + i_log
    m_loc = a.max(axis=-1)
    w = jnp.exp(a - m_loc[..., None])
    c_chunk = jnp.einsum('bhnt,bhntk,bhntv->bhnkv', w, kh, vh)
    n_chunk = jnp.einsum('bhnt,bhntk->bhnk', w, kh)

    def step(carry, xs):
        c, n, m = carry
        cc, ncv, mc, gc = xs
        m_new = jnp.maximum(gc + m, mc)
        dec = jnp.exp(gc + m - m_new)
        inj = jnp.exp(mc - m_new)
        c_new = dec[..., None, None] * c + inj[..., None, None] * cc
        n_new = dec[..., None] * n + inj[..., None] * ncv
        return (c_new, n_new, m_new), (c, n, m)

    init = (jnp.zeros((bsz, B_HEADS, B_QK_DIM, B_V_DIM), f32),
            jnp.zeros((bsz, B_HEADS, B_QK_DIM), f32),
            jnp.zeros((bsz, B_HEADS), f32))
    xs = (jnp.moveaxis(c_chunk, 2, 0), jnp.moveaxis(n_chunk, 2, 0),
          jnp.moveaxis(m_loc, 2, 0), jnp.moveaxis(g, 2, 0))
    _, (c_prev, n_prev, m_prev) = lax.scan(step, init, xs)
    c_prev = jnp.moveaxis(c_prev, 0, 2)
    n_prev = jnp.moveaxis(n_prev, 0, 2)
    m_prev = jnp.moveaxis(m_prev, 0, 2)

    causal = jnp.tril(jnp.ones((BLOCK, BLOCK), dtype=bool))
    dlog = jnp.where(causal, b[..., :, None] - b[..., None, :] + i_log[..., None, :], -jnp.inf)
    inter = b + m_prev[..., None]
    m_t = jnp.maximum(inter, dlog.max(axis=-1))
    inter_w = jnp.exp(inter - m_t)
    attn = jnp.exp(dlog - m_t[..., None]) * jnp.einsum('bhntk,bhnsk->bhnts', qh, kh)
    num = (inter_w[..., None] * jnp.einsum('bhntk,bhnkv->bhntv', qh, c_prev)
           + jnp.einsum('bhnts,bhnsv->bhntv', attn, vh))
    den = inter_w * jnp.einsum('bhntk,bhnk->bhnt', qh, n_prev) + attn.sum(axis=-1)
    h_cell = num / jnp.maximum(jnp.abs(den), jnp.exp(-m_t))[..., None]
    h_cell = h_cell.transpose(0, 2, 3, 1, 4).reshape(bsz, L, B_WIDTH).astype(u.dtype)
    return jax.nn.sigmoid(o_pre) * h_cell * jax.nn.silu(z)


def setup_inputs(seed: int = 0) -> dict:
    key = jax.random.key(seed)
    ks = jax.random.split(key, 12)
    f32 = jnp.float32
    x = jax.random.normal(ks[0], (BATCH, SEQ, D_MODEL), f32)
    meta = jax.random.normal(ks[1], (N_META, D_MODEL), f32)
    norm_a = 1.0 + 0.02 * jax.random.normal(ks[2], (N_LAYERS_A, D_MODEL), f32)
    w_in_a = jax.random.normal(ks[3], (N_LAYERS_A, D_MODEL, A_IN), f32) * D_MODEL ** -0.5
    sinks_a = jax.random.normal(ks[4], (N_LAYERS_A, A_HEADS), f32)
    w_out_a = jax.random.normal(ks[5], (N_LAYERS_A, A_WIDTH, D_MODEL), f32) * A_WIDTH ** -0.5
    norm_b = 1.0 + 0.02 * jax.random.normal(ks[6], (N_LAYERS_B, D_MODEL), f32)
    w_in_b = jax.random.normal(ks[7], (N_LAYERS_B, D_MODEL, B_IN), f32) * D_MODEL ** -0.5
    i_bias = 0.1 * jax.random.normal(ks[8], (N_LAYERS_B, B_HEADS), f32)
    f_bias = jnp.linspace(3.0, 6.0, B_HEADS, dtype=f32)[None, :] + 0.1 * jax.random.normal(ks[9], (N_LAYERS_B, B_HEADS), f32)
    b_gates_b = jnp.concatenate([i_bias, f_bias], axis=-1)
    w_out_b = jax.random.normal(ks[10], (N_LAYERS_B, B_WIDTH, D_MODEL), f32) * B_WIDTH ** -0.5
    norm_f = 1.0 + 0.02 * jax.random.normal(ks[11], (D_MODEL,), f32)
    return {"x": x, "meta": meta, "norm_a": norm_a, "w_in_a": w_in_a, "sinks_a": sinks_a,
            "w_out_a": w_out_a, "norm_b": norm_b, "w_in_b": w_in_b, "b_gates_b": b_gates_b,
            "w_out_b": w_out_b, "norm_f": norm_f}


def reference(x, meta, norm_a, w_in_a, sinks_a, w_out_a, norm_b, w_in_b, b_gates_b, w_out_b, norm_f):
    bsz, seq, _ = x.shape
    L = N_PAD + N_META + seq
    h = jnp.concatenate([
        jnp.zeros((bsz, N_PAD, D_MODEL), x.dtype),
        jnp.broadcast_to(meta[None].astype(x.dtype), (bsz, N_META, D_MODEL)),
        x], axis=1)
    pos = jnp.arange(L) - N_PAD
    valid = pos >= 0
    for i in range(DEPTH):
        j = i // N_MIXERS
        if i % N_MIXERS == 0:
            y = swa_sink_mixer(rmsnorm(h, norm_a[j]), w_in_a[j], sinks_a[j], pos, valid)
            h = h + y @ w_out_a[j]
        else:
            y = mlstm_mixer(rmsnorm(h, norm_b[j]), w_in_b[j], b_gates_b[j], valid)
            h = h + y @ w_out_b[j]
    h = rmsnorm(h, norm_f)
    return h[:, N_PAD + N_META:]
```

```cpp
#include <hip/hip_runtime.h>
#include <cstdio>
#include <cstdint>
namespace pg8 {
#define PG8_LAS __attribute__((address_space(3)))
typedef unsigned short bf16_t;
typedef short bf16x8 __attribute__((ext_vector_type(8)));
typedef float f32x4 __attribute__((ext_vector_type(4)));
typedef unsigned u32x4 __attribute__((ext_vector_type(4)));
constexpr int BM = 256, BK = 64, HALF = 128, HTB = HALF * BK * 2  , STAGE_BYTES = 8 * HTB, NXCD = 8, WGM = 8;

__host__ __device__ __forceinline__ int lds_byte(int r, int c) { const int st = (r >> 4) * 2 + (c >> 5), rr = r & 15, cc = c & 31, ob = rr * 64 + cc * 2; return st * 1024 + (ob ^ (((ob >> 9) & 1) << 5)); }
__host__ __device__ __forceinline__ void stage_rc(int b, int& R, int& C) { const int st = b / 1024, sb = b % 1024, swz = sb ^ (((sb >> 9) & 1) << 5); R = (st >> 1) * 16 + swz / 64; C = (st & 1) * 32 + (swz % 64) / 2; }
__host__ __device__ __forceinline__ int perm32(int rho) { const int n = rho >> 4, i = rho & 15; return 8 * (i >> 2) + 4 * n + (i & 3); }

struct Unit { int pm, pn; };
struct Gemm { const bf16_t* A; const bf16_t* Bt; int M, N, K; };

struct StaticOrder {
    int nM, nN, nwg, G, c;
    __host__ __device__ void init(int M, int N, int G_, int c_) { nM = M / BM; nN = N / BM; nwg = nM * nN; G = G_; c = c_; }
    __host__ __device__ bool next(int i, Unit& u) const {
        const long L = (long)i * G + c; if (L >= nwg) return false;
        int wgid = (int)L; { const int q = nwg / NXCD, r = nwg % NXCD, xcd = wgid % NXCD, off = wgid / NXCD; wgid = (xcd < r ? xcd * (q + 1) : r * (q + 1) + (xcd - r) * q) + off; }
        const int nig = WGM * nN, gid = wgid / nig, fm = gid * WGM, gsz = (nM - fm) < WGM ? (nM - fm) : WGM;
        u.pm = fm + ((wgid % nig) % gsz); u.pn = (wgid % nig) / gsz; return true;
    }
    __device__ __forceinline__ void a_ready(const Unit&) const {}
    __device__ __forceinline__ void done(const Unit&) const {}
};

__device__ __forceinline__ unsigned cvt_pk_bf16(float lo, float hi) { unsigned r; asm volatile("v_cvt_pk_bf16_f32 %0, %1, %2" : "=v"(r) : "v"(lo), "v"(hi)); return r; }
template <class Epi, class Sched, bool ALIGN_EPI = false, bool SP2 = false>
__device__ __forceinline__ void gemm_phase(PG8_LAS unsigned char* lds, const Gemm g, const Sched& S, const Epi& E) {
    const int tid = threadIdx.x, wid = __builtin_amdgcn_readfirstlane(tid >> 6), lane = tid & 63, wr = wid >> 2, wc = wid & 3, fr = lane & 15, fq = lane >> 4;
    const int K = g.K, nt = K / BK;
    unsigned voffA[2], voffB[2];
#pragma unroll
    for (int i = 0; i < 2; ++i) { int R, C; stage_rc(tid * 16 + i * 8192, R, C); const int Rb = Epi::PERM ? ((R & ~31) + perm32(R & 31)) : R;
        voffA[i] = (unsigned)(R * K + C) * 2u; voffB[i] = (unsigned)(Rb * K + C) * 2u; }
    const size_t kstep = (size_t)(BK * 2);
    const size_t hstep = (size_t)HALF * K * 2;
    const size_t tstep = 2 * hstep;
    const unsigned ldsw = (unsigned)wid * 1024u;
    const int aoff = lds_byte(wr * 64 + fr, fq * 8), boff = lds_byte(wc * 32 + fr, fq * 8);
#define PG8_SA(b, h) (((b) * 2 + (h)) * HTB)
#define PG8_SB(b, h) ((4 + (b) * 2 + (h)) * HTB)
#define PG8_STAGE(bufoff, gbase, voff) do { _Pragma("unroll") for (int _i = 0; _i < 2; ++_i) \
        __builtin_amdgcn_global_load_lds((const unsigned*)((const char*)(gbase) + (voff)[_i]), (PG8_LAS unsigned*)(lds + (bufoff) + ldsw + _i * 8192), 16, 0, 0); } while (0)
#define PG8_LDA(dst, b, h) do { _Pragma("unroll") for (int m = 0; m < 4; ++m) _Pragma("unroll") for (int k = 0; k < 2; ++k) dst[m][k] = *(const PG8_LAS bf16x8*)(lds + PG8_SA(b, h) + aoff + m * 2048 + k * 1024); } while (0)
#define PG8_LDB(dst, b, h) do { _Pragma("unroll") for (int n = 0; n < 2; ++n) _Pragma("unroll") for (int k = 0; k < 2; ++k) dst[n][k] = *(const PG8_LAS bf16x8*)(lds + PG8_SB(b, h) + boff + n * 2048 + k * 1024); } while (0)
#define PG8_MMA(ai, bj, At, Bt) do { __builtin_amdgcn_s_setprio(1); _Pragma("unroll") for (int m = 0; m < 4; ++m) _Pragma("unroll") for (int n = 0; n < 2; ++n) _Pragma("unroll") for (int k = 0; k < 2; ++k) \
        acc[ai][bj][m][n] = __builtin_amdgcn_mfma_f32_16x16x32_bf16(Bt[n][k], At[m][k], acc[ai][bj][m][n], 0, 0, 0); __builtin_amdgcn_s_setprio(0); } while (0)
#define PG8_WAIT_V(n) asm volatile("s_waitcnt vmcnt(" #n ")" ::: "memory")
#define PG8_WAIT_L(n) asm volatile("s_waitcnt lgkmcnt(" #n ")" ::: "memory")
#define PG8_BAR __builtin_amdgcn_s_barrier()
#define PG8_SCHED __builtin_amdgcn_sched_barrier(0)
    Unit cur, nxt; int ui = 0;
    if (!S.next(0, cur)) return;
    f32x4 acc[2][2][4][2];
#pragma unroll
    for (int a = 0; a < 2; ++a)
#pragma unroll
        for (int b = 0; b < 2; ++b)
#pragma unroll
            for (int m = 0; m < 4; ++m)
#pragma unroll
                for (int n = 0; n < 2; ++n) acc[a][b][m][n] = (f32x4){0.f, 0.f, 0.f, 0.f};
    bf16x8 At[4][2], B0[2][2], B1[2][2];
    const char* cA = (const char*)g.A + (size_t)cur.pm * tstep; const char* cB = (const char*)g.Bt + (size_t)cur.pn * tstep;
    S.a_ready(cur);
    if constexpr (SP2) {
        PG8_STAGE(PG8_SB(0, 0), cB, voffB); PG8_STAGE(PG8_SB(0, 1), cB + hstep, voffB); PG8_STAGE(PG8_SA(0, 0), cA, voffA); PG8_STAGE(PG8_SA(0, 1), cA + hstep, voffA);
        if (wr == 1) PG8_BAR;
        PG8_WAIT_V(2); PG8_BAR;
        PG8_STAGE(PG8_SB(1, 0), cB + kstep, voffB); PG8_STAGE(PG8_SA(1, 0), cA + kstep, voffA); PG8_STAGE(PG8_SB(1, 1), cB + hstep + kstep, voffB);
        PG8_WAIT_V(6); PG8_BAR;
    } else {
        PG8_STAGE(PG8_SB(0, 0), cB, voffB); PG8_STAGE(PG8_SA(0, 0), cA, voffA); PG8_STAGE(PG8_SB(0, 1), cB + hstep, voffB); PG8_STAGE(PG8_SA(0, 1), cA + hstep, voffA);
        if (wr == 1) PG8_BAR;
        PG8_WAIT_V(4); PG8_BAR;
        PG8_STAGE(PG8_SB(1, 0), cB + kstep, voffB); PG8_STAGE(PG8_SA(1, 0), cA + kstep, voffA); PG8_STAGE(PG8_SB(1, 1), cB + hstep + kstep, voffB);
        PG8_WAIT_V(6); PG8_BAR;
    }
    for (;;) {
        const bool has_next = S.next(ui + 1, nxt);
        const char* nA = has_next ? (const char*)g.A + (size_t)nxt.pm * tstep : cA; const char* nB = has_next ? (const char*)g.Bt + (size_t)nxt.pn * tstep : cB;
        for (int t = 0; t < nt; t += 2) {
            const bool last = (t == nt - 2);
            const char* a1 = cA + (size_t)(t + 1) * kstep;
            const char* a2 = last ? nA : cA + (size_t)(t + 2) * kstep; const char* b2 = last ? nB : cB + (size_t)(t + 2) * kstep;
            const char* a3 = a2 + kstep; const char* b3 = b2 + kstep;
            if (last && has_next) S.a_ready(nxt);
            if constexpr (SP2) {
            PG8_LDB(B0, 0, 0); PG8_LDB(B1, 0, 1); PG8_SCHED; PG8_LDA(At, 0, 0); PG8_STAGE(PG8_SA(1, 1), a1 + hstep, voffA);
            PG8_WAIT_V(8); PG8_WAIT_L(0); PG8_BAR; PG8_MMA(0, 0, At, B0); PG8_MMA(0, 1, At, B1); PG8_BAR; PG8_SCHED;
            PG8_LDA(At, 0, 1); PG8_STAGE(PG8_SB(0, 0), b2, voffB); PG8_STAGE(PG8_SB(0, 1), b2 + hstep, voffB); PG8_STAGE(PG8_SA(0, 0), a2, voffA);
            PG8_WAIT_V(8); PG8_WAIT_L(0); PG8_BAR; PG8_MMA(1, 0, At, B0); PG8_MMA(1, 1, At, B1); PG8_BAR; PG8_SCHED;
            PG8_LDB(B0, 1, 0); PG8_LDB(B1, 1, 1); PG8_SCHED; PG8_LDA(At, 1, 0); PG8_STAGE(PG8_SA(0, 1), a2 + hstep, voffA);
            PG8_WAIT_V(8); PG8_WAIT_L(0); PG8_BAR; PG8_MMA(0, 0, At, B0); PG8_MMA(0, 1, At, B1); PG8_BAR; PG8_SCHED;
            PG8_LDA(At, 1, 1); PG8_STAGE(PG8_SB(1, 0), b3, voffB); PG8_STAGE(PG8_SB(1, 1), b3 + hstep, voffB); PG8_STAGE(PG8_SA(1, 0), a3, voffA);
            PG8_WAIT_V(8); PG8_WAIT_L(0); PG8_BAR; PG8_MMA(1, 0, At, B0); PG8_MMA(1, 1, At, B1); PG8_BAR; PG8_SCHED;
            } else {
            PG8_LDB(B0, 0, 0); PG8_SCHED; PG8_LDA(At, 0, 0); PG8_STAGE(PG8_SA(1, 1), a1 + hstep, voffA);
            PG8_WAIT_L(8); PG8_BAR; PG8_WAIT_L(0); PG8_MMA(0, 0, At, B0); PG8_BAR; PG8_SCHED;
            PG8_LDB(B1, 0, 1); PG8_STAGE(PG8_SB(0, 0), b2, voffB);
            PG8_BAR; PG8_WAIT_L(0); PG8_MMA(0, 1, At, B1); PG8_BAR;
            PG8_LDA(At, 0, 1); PG8_STAGE(PG8_SA(0, 0), a2, voffA);
            PG8_BAR; PG8_WAIT_L(0); PG8_MMA(1, 0, At, B0); PG8_BAR; PG8_SCHED;
            PG8_STAGE(PG8_SB(0, 1), b2 + hstep, voffB);
            PG8_WAIT_V(6); PG8_BAR; PG8_MMA(1, 1, At, B1); PG8_BAR;
            PG8_LDB(B0, 1, 0); PG8_SCHED; PG8_LDA(At, 1, 0); PG8_STAGE(PG8_SA(0, 1), a2 + hstep, voffA);
            PG8_WAIT_L(8); PG8_BAR; PG8_WAIT_L(0); PG8_MMA(0, 0, At, B0); PG8_BAR; PG8_SCHED;
            PG8_LDB(B1, 1, 1); PG8_STAGE(PG8_SB(1, 0), b3, voffB);
            PG8_BAR; PG8_WAIT_L(0); PG8_MMA(0, 1, At, B1); PG8_BAR;
            PG8_LDA(At, 1, 1); PG8_STAGE(PG8_SA(1, 0), a3, voffA);
            PG8_BAR; PG8_WAIT_L(0); PG8_MMA(1, 0, At, B0); PG8_BAR; PG8_SCHED;
            PG8_STAGE(PG8_SB(1, 1), b3 + hstep, voffB);
            PG8_WAIT_V(6); PG8_BAR; PG8_MMA(1, 1, At, B1); PG8_BAR;
            }
        }
        if constexpr (ALIGN_EPI) { if (wr == 0) PG8_BAR; }
        if constexpr (!Epi::AFTER_DRAIN) { E(acc, cur, wr, wc, fr, fq); S.done(cur); }
        if (!has_next) break;
#pragma unroll
        for (int a = 0; a < 2; ++a)
#pragma unroll
            for (int b = 0; b < 2; ++b)
#pragma unroll
                for (int m = 0; m < 4; ++m)
#pragma unroll
                    for (int n = 0; n < 2; ++n) acc[a][b][m][n] = (f32x4){0.f, 0.f, 0.f, 0.f};
        cur = nxt; cA = nA; cB = nB; ++ui;
        if constexpr (ALIGN_EPI) { if (wr == 1) PG8_BAR; }
    }
    PG8_WAIT_V(0);
    if constexpr (!ALIGN_EPI) { if (wr == 0) PG8_BAR; }
    PG8_BAR;
    if constexpr (Epi::AFTER_DRAIN) { E.fused(acc, cur, wr, wc, fr, fq, lds, wid, lane); S.done(cur); }
#undef PG8_SA
#undef PG8_SB
#undef PG8_STAGE
#undef PG8_LDA
#undef PG8_LDB
#undef PG8_MMA
#undef PG8_WAIT_V
#undef PG8_WAIT_L
#undef PG8_BAR
#undef PG8_SCHED
}
}

#define DI __device__ __forceinline__
#define GAS __attribute__((address_space(1)))
#define LAS __attribute__((address_space(3)))
typedef unsigned short bf16;
typedef unsigned v4u __attribute__((ext_vector_type(4)));
typedef unsigned v2u __attribute__((ext_vector_type(2)));
typedef float f32x4 __attribute__((ext_vector_type(4)));
typedef short bf16x8 __attribute__((ext_vector_type(8)));
typedef GAS unsigned gu32;
typedef GAS unsigned long long gu64;
#define RLX_AGENT __ATOMIC_RELAXED, __HIP_MEMORY_SCOPE_AGENT
#define LDS_WAIT() asm volatile("s_waitcnt lgkmcnt(0)" ::: "memory")
#define VM_WAIT() asm volatile("s_waitcnt vmcnt(0)" ::: "memory")

constexpr int NWAVES = 8;
constexpr int DM = 1024, SEQ = 8192, NTOK = 2 * SEQ, RB0 = 128, NROW = NTOK + RB0;
constexpr int A_IN = 2304, B_MAIN = 4096, B_IN = 4112, NCHUNK = 65, NUNIT = 16 * NCHUNK;
constexpr float RMS_EPS = 1e-6f;
#ifndef MK_N_LAUNCHES
#define MK_N_LAUNCHES 10
#endif
constexpr int NPHASE = 10;
constexpr int N_LAUNCHES = MK_N_LAUNCHES;

constexpr size_t MiB = 1u << 20;
constexpr size_t WS_CTL = 0, CTL_ZERO_BYTES = 64 * 1024;
constexpr size_t WS_WA = 1 * MiB, WS_WOA = 6 * MiB, WS_WB = 8 * MiB, WS_WOB = 17 * MiB;
constexpr size_t WS_RSTD0 = 19 * MiB, WS_SSQ1 = 20 * MiB, WS_GATES = 22 * MiB, WS_SSQ2 = 24 * MiB, WS_STAT = 25 * MiB;
constexpr size_t ST_NCHK = 0, ST_MLOC = 512 * 1024, ST_GTOT = 520 * 1024, ST_MPREV = 528 * 1024, ST_NPREV = 544 * 1024;
constexpr size_t WS_RA = 26 * MiB;
constexpr size_t WS_RB = 59 * MiB;
constexpr size_t WS_RC = 92 * MiB;
constexpr size_t WS_K = 125 * MiB, WS_V = 130 * MiB;
constexpr size_t WS_PB = 92 * MiB;
constexpr size_t WS_G = 157 * MiB;
constexpr size_t WS_END = 190 * MiB;
constexpr size_t OUT_CCH = 0, OUT_CPREV = 33 * MiB;
static_assert(WS_WA + (size_t)A_IN * DM * 2 <= WS_WOA && WS_WB + (size_t)B_IN * DM * 2 <= WS_WOB && WS_RA + (size_t)NROW * DM * 2 <= WS_RB && WS_RB + (size_t)NROW * DM * 2 <= WS_RC, "ws map");
static_assert(WS_RC + (size_t)NROW * DM * 2 <= WS_K && WS_K + (size_t)NROW * 256 <= WS_V && WS_V + (size_t)NROW * 256 <= WS_G && WS_PB + (size_t)NROW * 4096 <= WS_G && WS_G + (size_t)NROW * 2048 <= WS_END, "ws map");
static_assert((size_t)NUNIT * 8192 * 4 <= OUT_CPREV && OUT_CPREV + (size_t)NUNIT * 8192 * 2 <= (size_t)NTOK * DM * 4, "d_out scratch map");
constexpr int CW_BAR = 4096;
constexpr int LDS_BYTES = 163840;
constexpr int RING_BYTES = 131072, LDSCTL_OFF = 160 * 1024 - 512, MISC_OFF = LDSCTL_OFF + 320;

DI float bf2f(bf16 b) { return __uint_as_float((unsigned)b << 16); }
DI unsigned f2bf(float f) { unsigned u = __float_as_uint(f); return (u + 0x7fffu + ((u >> 16) & 1u)) >> 16; }
DI unsigned pk2(float lo, float hi) { return f2bf(lo) | (f2bf(hi) << 16); }
DI float blo(unsigned w) { return __uint_as_float(w << 16); }
DI float bhi(unsigned w) { return __uint_as_float(w & 0xffff0000u); }
DI float wave_sum(float v) {
#pragma unroll
    for (int o = 1; o < 64; o <<= 1) v += __shfl_xor(v, o);
    return v;
}
DI float wave_max(float v) {
#pragma unroll
    for (int o = 1; o < 64; o <<= 1) v = fmaxf(v, __shfl_xor(v, o));
    return v;
}
DI float sigmoidf_(float x) { return 1.0f / (1.0f + __expf(-x)); }
DI float siluf_(float x) { return x / (1.0f + __expf(-x)); }
DI float logsigmoidf_(float x) { return fminf(x, 0.f) - __logf(1.0f + __expf(-fabsf(x))); }
DI float dot8(v4u a, v4u b) {
    return blo(a.x) * blo(b.x) + bhi(a.x) * bhi(b.x) + blo(a.y) * blo(b.y) + bhi(a.y) * bhi(b.y) + blo(a.z) * blo(b.z) + bhi(a.z) * bhi(b.z) + blo(a.w) * blo(b.w) + bhi(a.w) * bhi(b.w);
}

constexpr float ROPE_C = 0.41524101186092029f;
DI void rope_pair(float& x1, float& x2, float pos, float inv) {
    const float ang = pos * inv;
    float rev = ang * 0.15915494309189535f; rev = rev - floorf(rev);
    const float s = __builtin_amdgcn_sinf(rev), c = __builtin_amdgcn_cosf(rev);
    const float o1 = x1 * c - x2 * s, o2 = x2 * c + x1 * s; x1 = o1; x2 = o2;
}
struct ADst { bf16* Q; bf16* K; bf16* V; bf16* SZ; };
DI void epiA_quad(f32x4 v, int r, int gcol, float pos, const ADst& d) {
    float a = v[0], b = v[1], c = v[2], e = v[3]; bf16* dst;
    if (gcol < 1152) {
        const int i0 = (gcol & 63) >> 1;
        rope_pair(a, b, pos, __builtin_amdgcn_exp2f(-(float)i0 * ROPE_C)); rope_pair(c, e, pos, __builtin_amdgcn_exp2f(-(float)(i0 + 1) * ROPE_C));
        dst = gcol < 1024 ? d.Q + (size_t)r * DM + gcol : d.K + (size_t)r * 128 + (gcol - 1024);
    } else if (gcol < 1280) dst = d.V + (size_t)r * 128 + (gcol - 1152);
    else { a = siluf_(a); b = siluf_(b); c = siluf_(c); e = siluf_(e); dst = d.SZ + (size_t)r * DM + (gcol - 1280); }
    v2u w; w.x = pg8::cvt_pk_bf16(a, b); w.y = pg8::cvt_pk_bf16(c, e); *(v2u*)dst = w;
}
struct EpiA {
    static constexpr bool PERM = true, AFTER_DRAIN = false;
    ADst d; const float* rstd0;
    DI void operator()(const pg8::f32x4 (&acc)[2][2][4][2], const pg8::Unit& u, int wr, int wc, int fr, int fq) const {
        float rs[2][4];
#pragma unroll
        for (int ai = 0; ai < 2; ++ai)
#pragma unroll
            for (int m = 0; m < 4; ++m) rs[ai][m] = rstd0[RB0 + u.pm * 256 + ai * 128 + wr * 64 + m * 16 + fr];
#pragma unroll
        for (int bj = 0; bj < 2; ++bj) {
            const int gc = u.pn * 256 + bj * 128, gcol = gc + wc * 32 + 8 * fq;
            if (gc < 1152) {
                const int i0 = (gcol & 63) >> 1; float inv[4];
#pragma unroll
                for (int p = 0; p < 4; ++p) inv[p] = __builtin_amdgcn_exp2f(-(float)(i0 + p) * ROPE_C);
                bf16* base = gc < 1024 ? d.Q + gcol : d.K + (gcol - 1024); const int ld = gc < 1024 ? DM : 128;
#pragma unroll
                for (int ai = 0; ai < 2; ++ai)
#pragma unroll
                    for (int m = 0; m < 4; ++m) {
                        const int rt = u.pm * 256 + ai * 128 + wr * 64 + m * 16 + fr; const float pos = (float)(16 + (rt & (SEQ - 1)));
                        f32x4 v0 = acc[ai][bj][m][0] * rs[ai][m], v1 = acc[ai][bj][m][1] * rs[ai][m];
                        float a0 = v0[0], a1 = v0[1], a2 = v0[2], a3 = v0[3], b0 = v1[0], b1 = v1[1], b2 = v1[2], b3 = v1[3];
                        rope_pair(a0, a1, pos, inv[0]); rope_pair(a2, a3, pos, inv[1]); rope_pair(b0, b1, pos, inv[2]); rope_pair(b2, b3, pos, inv[3]);
                        v4u w; w.x = pg8::cvt_pk_bf16(a0, a1); w.y = pg8::cvt_pk_bf16(a2, a3); w.z = pg8::cvt_pk_bf16(b0, b1); w.w = pg8::cvt_pk_bf16(b2, b3);
                        *(v4u*)(base + (size_t)(RB0 + rt) * ld) = w;
                    }
            } else {
                const bool isz = gc >= 1280;
                bf16* base = isz ? d.SZ + (gcol - 1280) : d.V + (gcol - 1152); const int ld = isz ? DM : 128;
#pragma unroll
                for (int ai = 0; ai < 2; ++ai)
#pragma unroll
                    for (int m = 0; m < 4; ++m) {
                        const int rt = u.pm * 256 + ai * 128 + wr * 64 + m * 16 + fr;
                        f32x4 v0 = acc[ai][bj][m][0] * rs[ai][m], v1 = acc[ai][bj][m][1] * rs[ai][m];
                        if (isz) {
#pragma unroll
                            for (int j = 0; j < 4; ++j) { v0[j] = siluf_(v0[j]); v1[j] = siluf_(v1[j]); } }
                        v4u w; w.x = pg8::cvt_pk_bf16(v0[0], v0[1]); w.y = pg8::cvt_pk_bf16(v0[2], v0[3]); w.z = pg8::cvt_pk_bf16(v1[0], v1[1]); w.w = pg8::cvt_pk_bf16(v1[2], v1[3]);
                        *(v4u*)(base + (size_t)(RB0 + rt) * ld) = w;
                    }
            }
        }
    }
};
DI void row_partials_reduce(const float (&ss)[2][4], float* dst  , LAS float* xl, int wr, int wc, int fr, int fq) {
#pragma unroll
    for (int ai = 0; ai < 2; ++ai)
#pragma unroll
        for (int m = 0; m < 4; ++m) if (fq == 0) xl[(ai * 128 + wr * 64 + m * 16 + fr) * 4 + wc] = ss[ai][m];
    asm volatile("s_waitcnt lgkmcnt(0)" ::: "memory"); __builtin_amdgcn_s_barrier(); asm volatile("" ::: "memory");
    const int t = threadIdx.x;
    if (t < 256) { const f32x4 p = *(const LAS f32x4*)(xl + t * 4); dst[t] = (p[0] + p[1]) + (p[2] + p[3]); }
}
struct EpiOutA {
    static constexpr bool PERM = true, AFTER_DRAIN = false;
    const float* x; bf16* H1; float* ssq; LAS float* xl;
    DI void operator()(const pg8::f32x4 (&acc)[2][2][4][2], const pg8::Unit& u, int wr, int wc, int fr, int fq) const {
        float ssv[2][4];
#pragma unroll
        for (int ai = 0; ai < 2; ++ai)
#pragma unroll
            for (int m = 0; m < 4; ++m) {
                const int rt = u.pm * 256 + ai * 128 + wr * 64 + m * 16 + fr; float ss = 0.f;
#pragma unroll
                for (int bj = 0; bj < 2; ++bj) {
                    const int col = u.pn * 256 + bj * 128 + wc * 32 + 8 * fq;
                    const f32x4 x0 = *(const f32x4*)(x + (size_t)rt * DM + col), x1 = *(const f32x4*)(x + (size_t)rt * DM + col + 4);
                    const f32x4 h0 = x0 + acc[ai][bj][m][0], h1 = x1 + acc[ai][bj][m][1];
                    ss += (h0[0] * h0[0] + h0[1] * h0[1]) + (h0[2] * h0[2] + h0[3] * h0[3]) + (h1[0] * h1[0] + h1[1] * h1[1]) + (h1[2] * h1[2] + h1[3] * h1[3]);
                    v4u w; w.x = pg8::cvt_pk_bf16(h0[0], h0[1]); w.y = pg8::cvt_pk_bf16(h0[2], h0[3]); w.z = pg8::cvt_pk_bf16(h1[0], h1[1]); w.w = pg8::cvt_pk_bf16(h1[2], h1[3]);
                    *(v4u*)(H1 + (size_t)(RB0 + rt) * DM + col) = w;
                }
                ss += __shfl_xor(ss, 16); ss += __shfl_xor(ss, 32); ssv[ai][m] = ss;
            }
        row_partials_reduce(ssv, ssq + (size_t)u.pn * NROW + RB0 + u.pm * 256, xl, wr, wc, fr, fq);
    }
};
DI float rstd_from4(const float* ssq, int stride, int r) {
    const float s = (ssq[r] + ssq[(size_t)stride + r]) + (ssq[(size_t)2 * stride + r] + ssq[(size_t)3 * stride + r]);
    return 1.0f / sqrtf(s * (1.0f / DM) + RMS_EPS);
}
DI float rstd_from16(const float* ssq, int stride, int r) {
    float s = 0.f;
#pragma unroll
    for (int p = 0; p < 16; ++p) s += ssq[(size_t)p * stride + r];
    return 1.0f / sqrtf(s * (1.0f / DM) + RMS_EPS);
}
DI float gate_oz(float o, float z) { return z / ((1.0f + __expf(-o)) * (1.0f + __expf(-z))); }
DI void epiB_quad(f32x4 v, int r, int gcol, bf16* PB, bf16* G) {
    if (gcol < 2048) { v2u w; w.x = pg8::cvt_pk_bf16(v[0], v[1]); w.y = pg8::cvt_pk_bf16(v[2], v[3]); *(v2u*)(PB + (size_t)r * 2048 + gcol) = w; }
    else { *(unsigned*)(G + (size_t)r * DM + ((gcol - 2048) >> 1)) = pg8::cvt_pk_bf16(gate_oz(v[0], v[1]), gate_oz(v[2], v[3])); }
}
struct EpiB {
    static constexpr bool PERM = true, AFTER_DRAIN = false;
    const float* ssq1; bf16* PB; bf16* G;
    DI void operator()(const pg8::f32x4 (&acc)[2][2][4][2], const pg8::Unit& u, int wr, int wc, int fr, int fq) const {
#pragma unroll
        for (int ai = 0; ai < 2; ++ai)
#pragma unroll
            for (int m = 0; m < 4; ++m) {
                const int r = RB0 + u.pm * 256 + ai * 128 + wr * 64 + m * 16 + fr;
                const float rs = rstd_from4(ssq1, NROW, r);
#pragma unroll
                for (int bj = 0; bj < 2; ++bj) {
                    const int gc = u.pn * 256 + bj * 128, gcol = gc + wc * 32 + 8 * fq;
                    const f32x4 v0 = acc[ai][bj][m][0] * rs, v1 = acc[ai][bj][m][1] * rs;
                    if (gc < 2048) {
                        v4u w; w.x = pg8::cvt_pk_bf16(v0[0], v0[1]); w.y = pg8::cvt_pk_bf16(v0[2], v0[3]); w.z = pg8::cvt_pk_bf16(v1[0], v1[1]); w.w = pg8::cvt_pk_bf16(v1[2], v1[3]);
                        *(v4u*)(PB + (size_t)r * 2048 + gcol) = w;
                    } else {
                        v2u w; w.x = pg8::cvt_pk_bf16(gate_oz(v0[0], v0[1]), gate_oz(v0[2], v0[3])); w.y = pg8::cvt_pk_bf16(gate_oz(v1[0], v1[1]), gate_oz(v1[2], v1[3]));
                        *(v2u*)(G + (size_t)r * DM + ((gcol - 2048) >> 1)) = w;
                    }
                }
            }
    }
};
struct EpiOutB {
    static constexpr bool PERM = true, AFTER_DRAIN = false;
    const bf16* H1; float* out; float* ssq; LAS float* xl;
    DI void operator()(const pg8::f32x4 (&acc)[2][2][4][2], const pg8::Unit& u, int wr, int wc, int fr, int fq) const {
        float ssv[2][4];
#pragma unroll
        for (int ai = 0; ai < 2; ++ai)
#pragma unroll
            for (int m = 0; m < 4; ++m) {
                const int rt = u.pm * 256 + ai * 128 + wr * 64 + m * 16 + fr; float ss = 0.f;
#pragma unroll
                for (int bj = 0; bj < 2; ++bj) {
                    const int col = u.pn * 256 + bj * 128 + wc * 32 + 8 * fq;
                    const v4u hw = *(const v4u*)(H1 + (size_t)(RB0 + rt) * DM + col);
                    f32x4 h0 = acc[ai][bj][m][0], h1 = acc[ai][bj][m][1];
                    h0[0] += blo(hw.x); h0[1] += bhi(hw.x); h0[2] += blo(hw.y); h0[3] += bhi(hw.y); h1[0] += blo(hw.z); h1[1] += bhi(hw.z); h1[2] += blo(hw.w); h1[3] += bhi(hw.w);
                    ss += (h0[0] * h0[0] + h0[1] * h0[1]) + (h0[2] * h0[2] + h0[3] * h0[3]) + (h1[0] * h1[0] + h1[1] * h1[1]) + (h1[2] * h1[2] + h1[3] * h1[3]);
                    *(f32x4*)(out + (size_t)rt * DM + col) = h0; *(f32x4*)(out + (size_t)rt * DM + col + 4) = h1;
                }
                ss += __shfl_xor(ss, 16); ss += __shfl_xor(ss, 32); ssv[ai][m] = ss;
            }
        row_partials_reduce(ssv, ssq + (size_t)u.pn * NTOK + u.pm * 256, xl, wr, wc, fr, fq);
    }
};

DI f32x4 thin_tile(const bf16* A, const bf16* Wt, int lane) {
    const bf16* ap = A + (size_t)(lane & 15) * DM + 8 * (lane >> 4);
    const bf16* bp = Wt + (size_t)(lane & 15) * DM + 8 * (lane >> 4);
    f32x4 acc = (f32x4){0.f, 0.f, 0.f, 0.f};
#pragma unroll 8
    for (int k0 = 0; k0 < DM; k0 += 32) {
        const bf16x8 a = *(const bf16x8*)(ap + k0), b = *(const bf16x8*)(bp + k0);
        acc = __builtin_amdgcn_mfma_f32_16x16x32_bf16(b, a, acc, 0, 0, 0);
    }
    return acc;
}

struct Frame {
    LAS unsigned char* lds;
    volatile LAS unsigned* MISC;
    gu32* ctl;
    int tid, lane, wave, G;
    const float *x, *meta, *norm_a, *w_in_a, *sinks, *w_out_a, *norm_b, *w_in_b, *b_gates, *w_out_b, *norm_f; float* out;
    bf16 *WA, *WOA, *WB, *WOB;
    float *RSTD0, *SSQ1, *SSQM, *GATES, *SSQ2, *NCHK, *MLOC, *GTOT, *MPREV, *NPREV, *CCH;
    bf16 *XB, *YA, *YB, *Q, *H1, *SZ, *K, *V, *PB, *GG, *CPREV;
};

struct ColMapA {
    DI int col(int n) const { if (n < 1152) { const int hd = n >> 6, j = n & 63; return hd * 64 + (j >> 1) + 32 * (j & 1); } return n; }
    DI float scale(int) const { return 1.f; }
};
struct ColMapB {
    DI int col(int n) const { if (n >= 2048 && n < 4096) { const int j = (n - 2048) >> 1, e = n & 1; return 2048 + j + 1024 * e; } return n; }
    DI float scale(int n) const { return (n >= 512 && n < 1024) ? 0.125f : 1.f; }
};
struct ColMapId { DI int col(int n) const { return n; } DI float scale(int) const { return 1.f; } };
template <class CM>
DI void p0_item(const float* W, int K, int Nsrc, int Ndst, bf16* WT, const float* gain, LAS float* scr, int item, int lane, CM cm) {
    const int nblk = (Ndst + 31) / 32, kb = item / nblk, nb = item % nblk, k0 = 64 * kb, n0 = 32 * nb;
    const int nn = n0 + (lane & 31); const bool okc = nn < Ndst; const int src = okc ? cm.col(nn) : 0; const float sc = cm.scale(nn);
#pragma unroll 8
    for (int i = 0; i < 32; ++i) { const int kk = 2 * i + (lane >> 5); float v = 0.f;
        if (okc) { v = W[(size_t)(k0 + kk) * Nsrc + src] * sc; if (gain) v *= gain[k0 + kk]; }
        scr[kk * 33 + (lane & 31)] = v; }
    LDS_WAIT(); asm volatile("" ::: "memory");
    const int c = lane & 7;
#pragma unroll
    for (int j = 0; j < 4; ++j) { const int n = (lane >> 3) + 8 * j; const LAS float* s = scr + (8 * c) * 33 + n;
        v4u o; o.x = pk2(s[0 * 33], s[1 * 33]); o.y = pk2(s[2 * 33], s[3 * 33]); o.z = pk2(s[4 * 33], s[5 * 33]); o.w = pk2(s[6 * 33], s[7 * 33]);
        if (n0 + n < Ndst) *(GAS v4u*)(WT + (size_t)(n0 + n) * K + k0 + 8 * c) = o; }
    LDS_WAIT(); asm volatile("" ::: "memory");
}
DI void p0_row(const float* src, bf16* dst, float* rstd_out, int lane) {
    const GAS f32x4* xr = (const GAS f32x4*)src + lane;
    f32x4 v[4]; float s = 0.f;
#pragma unroll
    for (int j = 0; j < 4; ++j) { v[j] = xr[64 * j]; s += (v[j].x * v[j].x + v[j].y * v[j].y) + (v[j].z * v[j].z + v[j].w * v[j].w); }
    s = wave_sum(s);
    GAS v2u* o8 = (GAS v2u*)dst + lane;
#pragma unroll
    for (int j = 0; j < 4; ++j) { v2u w; w.x = pk2(v[j].x, v[j].y); w.y = pk2(v[j].z, v[j].w); o8[64 * j] = w; }
    if (lane == 0) *rstd_out = 1.0f / sqrtf(s * (1.0f / DM) + RMS_EPS);
}
DI void p0_prologue(Frame& F) {
    LAS float* scr = (LAS float*)(F.lds + F.wave * 16384);
    const int gw = blockIdx.x * NWAVES + F.wave, NGW = F.G * NWAVES;
    constexpr int I_A = 16 * 72, I_OA = 16 * 32, I_B = 16 * 129, I_OB = 16 * 32;
    for (int it = gw; it < I_A + I_OA + I_B + I_OB; it += NGW) {
        int r = it;
        if (r < I_A) { p0_item(F.w_in_a, DM, A_IN, A_IN, F.WA, F.norm_a, scr, r, F.lane, ColMapA()); continue; } r -= I_A;
        if (r < I_OA) { p0_item(F.w_out_a, DM, DM, DM, F.WOA, (const float*)nullptr, scr, r, F.lane, ColMapId()); continue; } r -= I_OA;
        if (r < I_B) { p0_item(F.w_in_b, DM, B_IN, B_IN, F.WB, F.norm_b, scr, r, F.lane, ColMapB()); continue; } r -= I_B;
        p0_item(F.w_out_b, DM, DM, DM, F.WOB, (const float*)nullptr, scr, r, F.lane, ColMapId());
    }
    for (int m = gw; m < 16 + NTOK; m += NGW) {
        if (m < 16) p0_row(F.meta + (size_t)m * DM, F.XB + (size_t)(112 + m) * DM, F.RSTD0 + 112 + m, F.lane);
        else p0_row(F.x + (size_t)(m - 16) * DM, F.XB + (size_t)(RB0 + m - 16) * DM, F.RSTD0 + RB0 + m - 16, F.lane);
    }
    const int gt = blockIdx.x * (NWAVES * 64) + F.tid;
    if (gt < 112 * 128 * 2 / 16) { ((v4u*)F.K)[gt] = (v4u){0u, 0u, 0u, 0u}; ((v4u*)F.V)[gt] = (v4u){0u, 0u, 0u, 0u}; }
}

DI void phase_inproj_a(Frame& F) {
    const ADst d{F.Q, F.K, F.V, F.SZ};
    { const int gw = blockIdx.x * NWAVES + F.wave;
      if (gw < A_IN / 16) {
          const f32x4 acc = thin_tile(F.XB + (size_t)112 * DM, F.WA + (size_t)gw * 16 * DM, F.lane);
          const int row = 112 + (F.lane & 15);
          epiA_quad(acc * F.RSTD0[row], row, 16 * gw + 4 * (F.lane >> 4), (float)(F.lane & 15), d);
      } }
    pg8::Gemm g{F.XB + (size_t)RB0 * DM, F.WA, NTOK, A_IN, DM}; pg8::StaticOrder S; S.init(NTOK, A_IN, F.G, (int)blockIdx.x);
    EpiA E{d, F.RSTD0};
    pg8::gemm_phase<EpiA, pg8::StaticOrder, true, true>(F.lds, g, S, E);
}

DI void phase_attn_naive(Frame& F) {
    const int gw = blockIdx.x * NWAVES + F.wave, NGW = F.G * NWAVES, lane = F.lane;
    for (int task = gw; task < (16 + NTOK) * 16; task += NGW) {
        const int head = task & 15, qi = task >> 4, kvh = head >> 3;
        int r, b, p;
        if (qi < 16) { r = 112 + qi; b = 0; p = r; } else { const int tok = qi - 16; b = tok >> 13; p = RB0 + (tok & (SEQ - 1)); r = RB0 + tok; }
        const bf16* qp = F.Q + (size_t)r * DM + head * 64;
        float s[2];
#pragma unroll
        for (int jj = 0; jj < 2; ++jj) {
            const int pk = p - 127 + lane + 64 * jj; const bool valid = pk >= 112; const int kr = valid ? (pk < RB0 ? pk : b * SEQ + pk) : 112;
            const bf16* kp = F.K + (size_t)kr * 128 + kvh * 64; float a = 0.f;
#pragma unroll
            for (int c = 0; c < 8; ++c) a += dot8(*(const v4u*)(qp + 8 * c), *(const v4u*)(kp + 8 * c));
            s[jj] = valid ? a * 0.125f : -INFINITY;
        }
        const float sink = F.sinks[head];
        const float m = fmaxf(wave_max(fmaxf(s[0], s[1])), sink);
        const float p0 = __expf(s[0] - m), p1 = __expf(s[1] - m);
        const float l = wave_sum(p0 + p1) + __expf(sink - m);
        float o = 0.f;
        for (int j = 0; j < 64; ++j) { const int pk = p - 127 + j; const float pj = __shfl(p0, j);
            if (pk >= 112) { const int kr = pk < RB0 ? pk : b * SEQ + pk; o += pj * bf2f(F.V[(size_t)kr * 128 + kvh * 64 + lane]); } }
        for (int j = 0; j < 64; ++j) { const int pk = p - 63 + j; const float pj = __shfl(p1, j);
            if (pk >= 112) { const int kr = pk < RB0 ? pk : b * SEQ + pk; o += pj * bf2f(F.V[(size_t)kr * 128 + kvh * 64 + lane]); } }
        o /= l;
        const size_t oi = (size_t)r * DM + head * 64 + lane;
        F.YA[oi] = (bf16)f2bf(o * bf2f(F.SZ[oi]));
    }
}

DI void phase_outproj_a(Frame& F) {
    { const int gw = blockIdx.x * NWAVES + F.wave;
      if (gw < 16) {
          const int row = 112 + (F.lane & 15); float ss = 0.f;
#pragma unroll
          for (int tt = 0; tt < 4; ++tt) {
              const f32x4 acc = thin_tile(F.YA + (size_t)112 * DM, F.WOA + (size_t)(gw * 64 + tt * 16) * DM, F.lane);
              const int col = gw * 64 + tt * 16 + 4 * (F.lane >> 4);
              const f32x4 h = *(const f32x4*)(F.meta + (size_t)(row - 112) * DM + col) + acc;
              ss += (h[0] * h[0] + h[1] * h[1]) + (h[2] * h[2] + h[3] * h[3]);
              v2u w; w.x = pg8::cvt_pk_bf16(h[0], h[1]); w.y = pg8::cvt_pk_bf16(h[2], h[3]); *(v2u*)(F.H1 + (size_t)row * DM + col) = w;
          }
          ss += __shfl_xor(ss, 16); ss += __shfl_xor(ss, 32);
          if (F.lane < 16) F.SSQM[gw * 16 + F.lane] = ss;
      } }
    pg8::Gemm g{F.YA + (size_t)RB0 * DM, F.WOA, NTOK, DM, DM}; pg8::StaticOrder S; S.init(NTOK, DM, F.G, (int)blockIdx.x);
    EpiOutA E{F.x, F.H1, F.SSQ1, (LAS float*)(F.lds + RING_BYTES)};
    pg8::gemm_phase<EpiOutA, pg8::StaticOrder, true, true>(F.lds, g, S, E);
}

DI void phase_inproj_b(Frame& F) {
    { const int gw = blockIdx.x * NWAVES + F.wave, NGW = F.G * NWAVES;
      for (int task = gw; task < 257 + NTOK / 16; task += NGW) {
          const int rowbase = task <= 256 ? 112 : RB0 + (task - 257) * 16, ntile = task < 256 ? task : 256;
          const f32x4 acc = thin_tile(F.H1 + (size_t)rowbase * DM, F.WB + (size_t)ntile * 16 * DM, F.lane);
          const int row = rowbase + (F.lane & 15), n4 = 4 * (F.lane >> 4);
          const float rs = task <= 256 ? rstd_from16(F.SSQM, 16, F.lane & 15) : rstd_from4(F.SSQ1, NROW, row);
          if (ntile < 256) epiB_quad(acc * rs, row, ntile * 16 + n4, F.PB, F.GG);
          else { const f32x4 bg = *(const f32x4*)(F.b_gates + n4); *(f32x4*)(F.GATES + (size_t)row * 16 + n4) = acc * rs + bg; }
      } }
    pg8::Gemm g{F.H1 + (size_t)RB0 * DM, F.WB, NTOK, B_MAIN, DM}; pg8::StaticOrder S; S.init(NTOK, B_MAIN, F.G, (int)blockIdx.x);
    EpiB E{F.SSQ1, F.PB, F.GG};
    pg8::gemm_phase<EpiB, pg8::StaticOrder, true, true>(F.lds, g, S, E);
}

DI int chunk_row0(int b, int n) { return n == 0 ? 0 : RB0 + b * SEQ + (n - 1) * 128; }
DI void phase_chunk_naive(Frame& F) {
    LAS bf16* KT = (LAS bf16*)(F.lds);
    LAS bf16* VT = (LAS bf16*)(F.lds + 16384);
    LAS float* SA = (LAS float*)(F.lds + 49152);
    const int tid = F.tid;
    for (int u = blockIdx.x; u < NUNIT; u += F.G) {
        const int bh = u / NCHUNK, n = u % NCHUNK, b = bh >> 3, h = bh & 7, row0 = chunk_row0(b, n);
        for (int c = tid; c < 1024; c += 512) { const int t = c >> 3, ch = c & 7; *(LAS v4u*)(KT + t * 64 + ch * 8) = *(const v4u*)(F.PB + (size_t)(row0 + t) * 2048 + 512 + h * 64 + ch * 8); }
        for (int c = tid; c < 2048; c += 512) { const int t = c >> 4, ch = c & 15; *(LAS v4u*)(VT + t * 128 + ch * 8) = *(const v4u*)(F.PB + (size_t)(row0 + t) * 2048 + 1024 + h * 128 + ch * 8); }
        if (tid < 128) { const bool valid = (n > 0) || (tid >= 112); const float* gp = F.GATES + (size_t)(row0 + tid) * 16;
            SA[tid] = valid ? logsigmoidf_(gp[8 + h]) : 0.f; SA[128 + tid] = valid ? gp[h] : -INFINITY; }
        __syncthreads();
        if (tid == 0) { float bs = 0.f; for (int t = 0; t < 128; ++t) { bs += SA[t]; SA[256 + t] = bs; } SA[512] = bs; }
        __syncthreads();
        const float g = SA[512];
        if (tid < 64) { const float a0 = g - SA[256 + tid] + SA[128 + tid], a1 = g - SA[256 + 64 + tid] + SA[128 + 64 + tid];
            const float ml = wave_max(fmaxf(a0, a1)); SA[384 + tid] = __expf(a0 - ml); SA[384 + 64 + tid] = __expf(a1 - ml); if (tid == 0) SA[513] = ml; }
        __syncthreads();
        { const int v = tid & 127, kg = tid >> 7; float acc[16];
#pragma unroll
          for (int kk = 0; kk < 16; ++kk) acc[kk] = 0.f;
          for (int t = 0; t < 128; ++t) { const float wv = SA[384 + t] * bf2f(VT[t * 128 + v]);
              const v4u k0 = *(const LAS v4u*)(KT + t * 64 + kg * 16), k1 = *(const LAS v4u*)(KT + t * 64 + kg * 16 + 8);
              acc[0] += wv * blo(k0.x); acc[1] += wv * bhi(k0.x); acc[2] += wv * blo(k0.y); acc[3] += wv * bhi(k0.y); acc[4] += wv * blo(k0.z); acc[5] += wv * bhi(k0.z); acc[6] += wv * blo(k0.w); acc[7] += wv * bhi(k0.w);
              acc[8] += wv * blo(k1.x); acc[9] += wv * bhi(k1.x); acc[10] += wv * blo(k1.y); acc[11] += wv * bhi(k1.y); acc[12] += wv * blo(k1.z); acc[13] += wv * bhi(k1.z); acc[14] += wv * blo(k1.w); acc[15] += wv * bhi(k1.w); }
          float* cp = F.CCH + (size_t)u * 8192 + v * 64 + kg * 16;
#pragma unroll
          for (int q = 0; q < 4; ++q) *(f32x4*)(cp + 4 * q) = (f32x4){acc[4 * q], acc[4 * q + 1], acc[4 * q + 2], acc[4 * q + 3]}; }
        if (tid < 64) { float a = 0.f; for (int t = 0; t < 128; ++t) a += SA[384 + t] * bf2f(KT[t * 64 + tid]); F.NCHK[(size_t)u * 64 + tid] = a; }
        if (tid == 0) { F.MLOC[u] = SA[513]; F.GTOT[u] = g; }
        __syncthreads();
    }
}

DI void phase_scan(Frame& F) {
    const int gid = blockIdx.x * (NWAVES * 64) + F.tid, NG = F.G * NWAVES * 64;
    for (int e = gid; e < 16 * 8192 + 16 * 64; e += NG) {
        const bool isn = e >= 16 * 8192; const int ee = isn ? e - 16 * 8192 : e;
        const int bh = isn ? ee >> 6 : ee >> 13, idx = isn ? ee & 63 : ee & 8191;
        const float* src = isn ? F.NCHK + (size_t)bh * NCHUNK * 64 + idx : F.CCH + (size_t)bh * NCHUNK * 8192 + idx; const int sstr = isn ? 64 : 8192;
        float c = 0.f, m = 0.f;
        for (int n0 = 0; n0 < NCHUNK; n0 += 13) {
            float cc[13];
#pragma unroll
            for (int i = 0; i < 13; ++i) cc[i] = src[(size_t)(n0 + i) * sstr];
#pragma unroll
            for (int i = 0; i < 13; ++i) {
                const int u = bh * NCHUNK + n0 + i; const float g = F.GTOT[u], ml = F.MLOC[u];
                if (isn) F.NPREV[(size_t)u * 64 + idx] = c; else { F.CPREV[(size_t)u * 8192 + idx] = (bf16)f2bf(c); if (idx == 0) F.MPREV[u] = m; }
                const float mn = fmaxf(g + m, ml), dec = __expf(g + m - mn), inj = __expf(ml - mn);
                c = dec * c + inj * cc[i]; m = mn;
            }
        }
    }
}

DI void phase_mlstm_out_naive(Frame& F) {
    LAS bf16* QT = (LAS bf16*)(F.lds);
    LAS bf16* KT = (LAS bf16*)(F.lds + 16384);
    LAS bf16* CP = (LAS bf16*)(F.lds + 32768);
    LAS bf16* VT = (LAS bf16*)(F.lds + 49152);
    LAS float* AT = (LAS float*)(F.lds + 81920);
    LAS float* SA = (LAS float*)(F.lds + 147456);
    const int tid = F.tid;
    for (int unit = blockIdx.x; unit < 16 * 64; unit += F.G) {
        const int bh = unit >> 6, n = 1 + (unit & 63), b = bh >> 3, h = bh & 7, u = bh * NCHUNK + n, row0 = chunk_row0(b, n);
        for (int c = tid; c < 1024; c += 512) { const int t = c >> 3, ch = c & 7; const bf16* rp = F.PB + (size_t)(row0 + t) * 2048 + h * 64 + ch * 8;
            *(LAS v4u*)(QT + t * 64 + ch * 8) = *(const v4u*)rp; *(LAS v4u*)(KT + t * 64 + ch * 8) = *(const v4u*)(rp + 512);
            *(LAS v4u*)(CP + c * 8) = *(const v4u*)(F.CPREV + (size_t)u * 8192 + c * 8); }
        for (int c = tid; c < 2048; c += 512) { const int t = c >> 4, ch = c & 15; *(LAS v4u*)(VT + t * 128 + ch * 8) = *(const v4u*)(F.PB + (size_t)(row0 + t) * 2048 + 1024 + h * 128 + ch * 8); }
        if (tid < 128) { const float* gp = F.GATES + (size_t)(row0 + tid) * 16; SA[tid] = logsigmoidf_(gp[8 + h]); SA[128 + tid] = gp[h]; }
        if (tid < 64) SA[896 + tid] = F.NPREV[(size_t)u * 64 + tid];
        __syncthreads();
        if (tid == 0) { const float mp = F.MPREV[u]; float bs = 0.f, pm = -INFINITY;
            for (int t = 0; t < 128; ++t) { bs += SA[t]; const float us = SA[128 + t] - bs; pm = fmaxf(pm, us); const float inter = bs + mp, mt = fmaxf(inter, bs + pm);
                SA[256 + t] = bs; SA[384 + t] = us; SA[512 + t] = mt; SA[640 + t] = __expf(inter - mt); } }
        __syncthreads();
#pragma unroll 1
        for (int i = 0; i < 32; ++i) { const int id = tid + 512 * i, t = id >> 7, s = id & 127; float val = 0.f;
            if (s <= t) { float d = 0.f;
#pragma unroll
                for (int c = 0; c < 8; ++c) d += dot8(*(const LAS v4u*)(QT + t * 64 + c * 8), *(const LAS v4u*)(KT + s * 64 + c * 8));
                val = __expf(SA[256 + t] + SA[384 + s] - SA[512 + t]) * d; }
            AT[t * 128 + s] = val; }
        __syncthreads();
        if (tid < 128) { const int t = tid; float qn = 0.f, rsum = 0.f;
            for (int k = 0; k < 64; ++k) qn += bf2f(QT[t * 64 + k]) * SA[896 + k];
            for (int s = 0; s <= t; ++s) rsum += AT[t * 128 + s];
            SA[768 + t] = SA[640 + t] * qn + rsum; }
        __syncthreads();
        { const int v = tid & 127, tg = tid >> 7;
#pragma unroll 1
          for (int t = tg * 32; t < tg * 32 + 32; ++t) {
              float acc = 0.f;
#pragma unroll
              for (int c = 0; c < 8; ++c) acc += dot8(*(const LAS v4u*)(QT + t * 64 + c * 8), *(const LAS v4u*)(CP + v * 64 + c * 8));
              acc *= SA[640 + t];
              for (int s = 0; s <= t; ++s) acc += AT[t * 128 + s] * bf2f(VT[s * 128 + v]);
              const float hc = acc / fmaxf(fabsf(SA[768 + t]), __expf(-SA[512 + t]));
              const size_t oi = (size_t)(row0 + t) * DM + h * 128 + v;
              F.YB[oi] = (bf16)f2bf(hc * bf2f(F.GG[oi]));
          } }
        __syncthreads();
    }
}

DI void phase_outproj_b(Frame& F) {
    pg8::Gemm g{F.YB + (size_t)RB0 * DM, F.WOB, NTOK, DM, DM}; pg8::StaticOrder S; S.init(NTOK, DM, F.G, (int)blockIdx.x);
    EpiOutB E{F.H1, F.out, F.SSQ2, (LAS float*)(F.lds + RING_BYTES)};
    pg8::gemm_phase<EpiOutB, pg8::StaticOrder, true, true>(F.lds, g, S, E);
}
DI void phase_final_norm(Frame& F) {
    const int gw = blockIdx.x * NWAVES + F.wave, NGW = F.G * NWAVES;
    f32x4 gn[4];
#pragma unroll
    for (int j = 0; j < 4; ++j) gn[j] = ((const f32x4*)F.norm_f)[F.lane + 64 * j];
    for (int m = gw; m < NTOK; m += NGW) {
        const float rs = rstd_from4(F.SSQ2, NTOK, m);
        GAS f32x4* o = (GAS f32x4*)(F.out + (size_t)m * DM) + F.lane;
#pragma unroll
        for (int j = 0; j < 4; ++j) o[64 * j] = o[64 * j] * rs * gn[j];
    }
}
#define XB_TMO      128
#define XB_XCNT(j)  (256  + 64 * (j))
#define XB_XSUB(j)  (1280 + 64 * (j))
#define XB_XGEN(j)  (2304 + 64 * (j))
#define XB_TOP      3328
#define XB_TOPGEN   3392
#define XCD_BAR_WORDS 3456
#define XB_SPIN_CAP (1u << 18)

__device__ __forceinline__ unsigned xb_ld(unsigned* p)              { return __hip_atomic_load(p, __ATOMIC_RELAXED, __HIP_MEMORY_SCOPE_AGENT); }
__device__ __forceinline__ unsigned xb_add(unsigned* p, unsigned v) { return __hip_atomic_fetch_add(p, v, __ATOMIC_RELAXED, __HIP_MEMORY_SCOPE_AGENT); }
__device__ __forceinline__ unsigned xb_xcc_id() { return (unsigned)__builtin_amdgcn_s_getreg((3 << 11) | 20) & 0xFu; }
#define XB_SPIN(cond, bar) do { unsigned _sp = 0; while (cond) { __builtin_amdgcn_s_sleep(1); \
    if ((++_sp & 255u) == 0u) { if (xb_ld(&(bar)[XB_TMO])) break; if (_sp > XB_SPIN_CAP) { atomicAdd(&(bar)[XB_TMO], 1u); break; } } } } while (0)

struct XcdBarrier {
    unsigned* bar; unsigned x;
    volatile LAS unsigned* st;
};

__device__ __forceinline__ XcdBarrier xcd_barrier_post(unsigned* bar, volatile LAS unsigned* st) {
    XcdBarrier b; b.bar = bar; b.x = xb_xcc_id(); b.st = st;
    if (threadIdx.x == 0) (void)xb_add(&bar[XB_XCNT(b.x)], 1u);
    return b;
}
__device__ __forceinline__ void xcd_barrier_complete(unsigned* bar, unsigned x, unsigned& nloc, unsigned& nx) {
    const unsigned G = gridDim.x * gridDim.y * gridDim.z;
    unsigned sum, cnt, mine, sp = 0u;
    for (;;) {
        sum = 0u; cnt = 0u; mine = 0u;
#pragma unroll
        for (unsigned j = 0; j < 16; ++j) { const unsigned c = xb_ld(&bar[XB_XCNT(j)]); sum += c; cnt += (c > 0u) ? 1u : 0u; mine = (j == x) ? c : mine; }
        if (sum == G) break;
        __builtin_amdgcn_s_sleep(1);
        if ((++sp & 255u) == 0u) { if (xb_ld(&bar[XB_TMO])) break; if (sp > XB_SPIN_CAP) { atomicAdd(&bar[XB_TMO], 1u); break; } }
    }
    nloc = mine > 0u ? mine : 1u; nx = cnt > 0u ? cnt : 1u;
}

__device__ __forceinline__ void xcd_barrier(const XcdBarrier& b) {
    asm volatile("s_waitcnt vmcnt(0)" ::: "memory");
    __syncthreads();
    if (threadIdx.x == 0) {
        unsigned* bar = b.bar;
        __builtin_amdgcn_s_waitcnt(0);
        unsigned nloc = b.st[0], nx = b.st[1];
        if (nloc == 0u) { xcd_barrier_complete(bar, b.x, nloc, nx); b.st[0] = nloc; b.st[1] = nx; }
        const unsigned old = xb_add(&bar[XB_XSUB(b.x)], 1u);
        const unsigned gen = old / nloc;
        if (old + 1u == (gen + 1u) * nloc) {
            __builtin_amdgcn_fence(__ATOMIC_RELEASE, "agent");
            asm volatile("s_waitcnt vmcnt(0)" ::: "memory");
            const unsigned og = xb_add(&bar[XB_TOP], 1u);
            const unsigned tg = og / nx;
            if (og + 1u == (tg + 1u) * nx) xb_add(&bar[XB_TOPGEN], 1u);
            else XB_SPIN(xb_ld(&bar[XB_TOPGEN]) == tg, bar);
            __builtin_amdgcn_fence(__ATOMIC_ACQUIRE, "agent");
            xb_add(&bar[XB_XGEN(b.x)], 1u);
            asm volatile("s_waitcnt vmcnt(0)" ::: "memory");
        } else {
            XB_SPIN(xb_ld(&bar[XB_XGEN(b.x)]) == gen, bar);
            __builtin_amdgcn_fence(__ATOMIC_ACQUIRE, "agent");
            asm volatile("s_waitcnt vmcnt(0)" ::: "memory");
        }
    }
    __syncthreads();
}

#ifndef PHASE_MASK
#define PHASE_MASK 0x3ff
#endif
struct Args { const float* in[11]; float* out; unsigned char* ws; int ph_lo, ph_hi; };
__global__ void __launch_bounds__(NWAVES * 64, 2) fwd_kernel(Args args) {
    extern __shared__ __attribute__((aligned(16))) unsigned char lds[];
    Frame F;
    F.lds = (LAS unsigned char*)lds;
    F.MISC = (volatile LAS unsigned*)(F.lds + MISC_OFF);
    F.tid = threadIdx.x; F.lane = F.tid & 63; F.wave = __builtin_amdgcn_readfirstlane(F.tid >> 6);
    F.G = gridDim.x;
    unsigned char* ws = args.ws;
    F.ctl = (gu32*)(ws + WS_CTL);
    F.x = args.in[0]; F.meta = args.in[1]; F.norm_a = args.in[2]; F.w_in_a = args.in[3]; F.sinks = args.in[4]; F.w_out_a = args.in[5];
    F.norm_b = args.in[6]; F.w_in_b = args.in[7]; F.b_gates = args.in[8]; F.w_out_b = args.in[9]; F.norm_f = args.in[10]; F.out = args.out;
    F.WA = (bf16*)(ws + WS_WA); F.WOA = (bf16*)(ws + WS_WOA); F.WB = (bf16*)(ws + WS_WB); F.WOB = (bf16*)(ws + WS_WOB);
    F.RSTD0 = (float*)(ws + WS_RSTD0); F.SSQ1 = (float*)(ws + WS_SSQ1); F.SSQM = (float*)(ws + WS_SSQ1 + MiB); F.GATES = (float*)(ws + WS_GATES); F.SSQ2 = (float*)(ws + WS_SSQ2);
    F.NCHK = (float*)(ws + WS_STAT + ST_NCHK); F.MLOC = (float*)(ws + WS_STAT + ST_MLOC); F.GTOT = (float*)(ws + WS_STAT + ST_GTOT);
    F.MPREV = (float*)(ws + WS_STAT + ST_MPREV); F.NPREV = (float*)(ws + WS_STAT + ST_NPREV);
    F.XB = (bf16*)(ws + WS_RA); F.YA = F.XB; F.YB = F.XB; F.Q = (bf16*)(ws + WS_RB); F.H1 = F.Q; F.SZ = (bf16*)(ws + WS_RC);
    F.K = (bf16*)(ws + WS_K); F.V = (bf16*)(ws + WS_V); F.PB = (bf16*)(ws + WS_PB); F.GG = (bf16*)(ws + WS_G);
    F.CCH = (float*)((unsigned char*)args.out + OUT_CCH); F.CPREV = (bf16*)((unsigned char*)args.out + OUT_CPREV);
    for (int u = F.tid; u < (LDS_BYTES - LDSCTL_OFF) / 4; u += NWAVES * 64) ((LAS unsigned*)(F.lds + LDSCTL_OFF))[u] = 0u;
    __syncthreads();
    XcdBarrier bar; bar.bar = (unsigned*)(F.ctl + CW_BAR); bar.x = 0; bar.st = nullptr;
    if (N_LAUNCHES == 1) bar = xcd_barrier_post((unsigned*)(F.ctl + CW_BAR), F.MISC + 8);
#define GRID_BAR() do { if (N_LAUNCHES == 1) xcd_barrier(bar); } while (0)
    const int lo = args.ph_lo, hi = args.ph_hi;
#define IN(k) (lo <= (k) && (k) < hi)
#define BOTH(k) (IN(k) && IN((k) + 1))
    if (((PHASE_MASK >> 0) & 1) && IN(0)) { p0_prologue(F); if (BOTH(0)) GRID_BAR(); }
    if (((PHASE_MASK >> 1) & 1) && IN(1)) { phase_inproj_a(F); if (BOTH(1)) GRID_BAR(); }
    if (((PHASE_MASK >> 2) & 1) && IN(2)) { phase_attn_naive(F); if (BOTH(2)) GRID_BAR(); }
    if (((PHASE_MASK >> 3) & 1) && IN(3)) { phase_outproj_a(F); if (BOTH(3)) GRID_BAR(); }
    if (((PHASE_MASK >> 4) & 1) && IN(4)) { phase_inproj_b(F); if (BOTH(4)) GRID_BAR(); }
    if (((PHASE_MASK >> 5) & 1) && IN(5)) { phase_chunk_naive(F); if (BOTH(5)) GRID_BAR(); }
    if (((PHASE_MASK >> 6) & 1) && IN(6)) { phase_scan(F); if (BOTH(6)) GRID_BAR(); }
    if (((PHASE_MASK >> 7) & 1) && IN(7)) { phase_mlstm_out_naive(F); if (BOTH(7)) GRID_BAR(); }
    if (((PHASE_MASK >> 8) & 1) && IN(8)) { phase_outproj_b(F); if (BOTH(8)) GRID_BAR(); }
    if (((PHASE_MASK >> 9) & 1) && IN(9)) { phase_final_norm(F); }
#undef IN
#undef BOTH
}

extern "C" void kernel_launch(void* const* d_in, const int* in_sizes, int n_in, void* d_out, int out_size, void* d_ws, size_t ws_size, hipStream_t stream) {
    static int grid = 0;
    if (grid == 0) {
        if (n_in != 11 || in_sizes[0] != NTOK * DM || out_size != NTOK * DM || ws_size < WS_END) { fprintf(stderr, "kernel_launch: unexpected shapes (n_in %d, in0 %d, out %d, ws %zu); nothing launched\n", n_in, n_in > 0 ? in_sizes[0] : -1, out_size, ws_size); grid = -1; return; }
        int dev = 0, cus = 0, per_cu = 0;
        if (hipGetDevice(&dev) != hipSuccess || hipDeviceGetAttribute(&cus, hipDeviceAttributeMultiprocessorCount, dev) != hipSuccess) { fprintf(stderr, "kernel_launch: device query failed\n"); grid = -1; return; }
        if (hipFuncSetAttribute((const void*)fwd_kernel, hipFuncAttributeMaxDynamicSharedMemorySize, LDS_BYTES) != hipSuccess) { fprintf(stderr, "kernel_launch: hipFuncSetAttribute failed\n"); grid = -1; return; }
        if (hipOccupancyMaxActiveBlocksPerMultiprocessor(&per_cu, (const void*)fwd_kernel, NWAVES * 64, LDS_BYTES) != hipSuccess || per_cu < 1) { fprintf(stderr, "kernel_launch: occupancy query reports %d workgroups per CU\n", per_cu); per_cu = 1; }
        (void)hipGetLastError();
        grid = cus;
        if (grid != 256) fprintf(stderr, "kernel_launch: %d CUs (expected 256)\n", grid);
    }
    if (grid < 0) return;
    (void)hipMemsetAsync((char*)d_ws + WS_CTL, 0, CTL_ZERO_BYTES, stream);
    Args a{};
    for (int i = 0; i < 11; ++i) a.in[i] = (const float*)d_in[i];
    a.out = (float*)d_out; a.ws = (unsigned char*)d_ws;
    if (N_LAUNCHES == 1) { a.ph_lo = 0; a.ph_hi = NPHASE; hipLaunchKernelGGL(fwd_kernel, dim3(grid), dim3(NWAVES * 64), LDS_BYTES, stream, a); }
    else for (int p = 0; p < NPHASE; ++p) { a.ph_lo = p; a.ph_hi = p + 1; hipLaunchKernelGGL(fwd_kernel, dim3(grid), dim3(NWAVES * 64), LDS_BYTES, stream, a); }
}
```

```cpp
#include <hip/hip_runtime.h>
#include <cstdio>
#include <cstdint>
namespace pg8 {
#define PG8_LAS __attribute__((address_space(3)))
typedef unsigned short bf16_t;
typedef short bf16x8 __attribute__((ext_vector_type(8)));
typedef float f32x4 __attribute__((ext_vector_type(4)));
typedef unsigned u32x4 __attribute__((ext_vector_type(4)));
constexpr int BM = 256, BK = 64, HALF = 128, HTB = HALF * BK * 2  , STAGE_BYTES = 8 * HTB, NXCD = 8, WGM = 8;

__host__ __device__ __forceinline__ int lds_byte(int r, int c) { const int st = (r >> 4) * 2 + (c >> 5), rr = r & 15, cc = c & 31, ob = rr * 64 + cc * 2; return st * 1024 + (ob ^ (((ob >> 9) & 1) << 5)); }
__host__ __device__ __forceinline__ void stage_rc(int b, int& R, int& C) { const int st = b / 1024, sb = b % 1024, swz = sb ^ (((sb >> 9) & 1) << 5); R = (st >> 1) * 16 + swz / 64; C = (st & 1) * 32 + (swz % 64) / 2; }
__host__ __device__ __forceinline__ int perm32(int rho) { const int n = rho >> 4, i = rho & 15; return 8 * (i >> 2) + 4 * n + (i & 3); }

struct Unit { int pm, pn; };
struct Gemm { const bf16_t* A; const bf16_t* Bt; int M, N, K; };

struct StaticOrder {
    int nM, nN, nwg, G, c;
    __host__ __device__ void init(int M, int N, int G_, int c_) { nM = M / BM; nN = N / BM; nwg = nM * nN; G = G_; c = c_; }
    __host__ __device__ bool next(int i, Unit& u) const {
        const long L = (long)i * G + c; if (L >= nwg) return false;
        int wgid = (int)L; { const int q = nwg / NXCD, r = nwg % NXCD, xcd = wgid % NXCD, off = wgid / NXCD; wgid = (xcd < r ? xcd * (q + 1) : r * (q + 1) + (xcd - r) * q) + off; }
        const int nig = WGM * nN, gid = wgid / nig, fm = gid * WGM, gsz = (nM - fm) < WGM ? (nM - fm) : WGM;
        u.pm = fm + ((wgid % nig) % gsz); u.pn = (wgid % nig) / gsz; return true;
    }
    __device__ __forceinline__ void a_ready(const Unit&) const {}
    __device__ __forceinline__ void done(const Unit&) const {}
};

__device__ __forceinline__ unsigned cvt_pk_bf16(float lo, float hi) { unsigned r; asm volatile("v_cvt_pk_bf16_f32 %0, %1, %2" : "=v"(r) : "v"(lo), "v"(hi)); return r; }
template <class Epi, class Sched, bool ALIGN_EPI = false, bool SP2 = false>
__device__ __forceinline__ void gemm_phase(PG8_LAS unsigned char* lds, const Gemm g, const Sched& S, const Epi& E) {
    const int tid = threadIdx.x, wid = __builtin_amdgcn_readfirstlane(tid >> 6), lane = tid & 63, wr = wid >> 2, wc = wid & 3, fr = lane & 15, fq = lane >> 4;
    const int K = g.K, nt = K / BK;
    unsigned voffA[2], voffB[2];
#pragma unroll
    for (int i = 0; i < 2; ++i) { int R, C; stage_rc(tid * 16 + i * 8192, R, C); const int Rb = Epi::PERM ? ((R & ~31) + perm32(R & 31)) : R;
        voffA[i] = (unsigned)(R * K + C) * 2u; voffB[i] = (unsigned)(Rb * K + C) * 2u; }
    const size_t kstep = (size_t)(BK * 2);
    const size_t hstep = (size_t)HALF * K * 2;
    const size_t tstep = 2 * hstep;
    const unsigned ldsw = (unsigned)wid * 1024u;
    const int aoff = lds_byte(wr * 64 + fr, fq * 8), boff = lds_byte(wc * 32 + fr, fq * 8);
#define PG8_SA(b, h) (((b) * 2 + (h)) * HTB)
#define PG8_SB(b, h) ((4 + (b) * 2 + (h)) * HTB)
#define PG8_STAGE(bufoff, gbase, voff) do { _Pragma("unroll") for (int _i = 0; _i < 2; ++_i) \
        __builtin_amdgcn_global_load_lds((const unsigned*)((const char*)(gbase) + (voff)[_i]), (PG8_LAS unsigned*)(lds + (bufoff) + ldsw + _i * 8192), 16, 0, 0); } while (0)
#define PG8_LDA(dst, b, h) do { _Pragma("unroll") for (int m = 0; m < 4; ++m) _Pragma("unroll") for (int k = 0; k < 2; ++k) dst[m][k] = *(const PG8_LAS bf16x8*)(lds + PG8_SA(b, h) + aoff + m * 2048 + k * 1024); } while (0)
#define PG8_LDB(dst, b, h) do { _Pragma("unroll") for (int n = 0; n < 2; ++n) _Pragma("unroll") for (int k = 0; k < 2; ++k) dst[n][k] = *(const PG8_LAS bf16x8*)(lds + PG8_SB(b, h) + boff + n * 2048 + k * 1024); } while (0)
#define PG8_MMA(ai, bj, At, Bt) do { __builtin_amdgcn_s_setprio(1); _Pragma("unroll") for (int m = 0; m < 4; ++m) _Pragma("unroll") for (int n = 0; n < 2; ++n) _Pragma("unroll") for (int k = 0; k < 2; ++k) \
        acc[ai][bj][m][n] = __builtin_amdgcn_mfma_f32_16x16x32_bf16(Bt[n][k], At[m][k], acc[ai][bj][m][n], 0, 0, 0); __builtin_amdgcn_s_setprio(0); } while (0)
#define PG8_WAIT_V(n) asm volatile("s_waitcnt vmcnt(" #n ")" ::: "memory")
#define PG8_WAIT_L(n) asm volatile("s_waitcnt lgkmcnt(" #n ")" ::: "memory")
#define PG8_BAR __builtin_amdgcn_s_barrier()
#define PG8_SCHED __builtin_amdgcn_sched_barrier(0)
    Unit cur, nxt; int ui = 0;
    if (!S.next(0, cur)) return;
    f32x4 acc[2][2][4][2];
#pragma unroll
    for (int a = 0; a < 2; ++a)
#pragma unroll
        for (int b = 0; b < 2; ++b)
#pragma unroll
            for (int m = 0; m < 4; ++m)
#pragma unroll
                for (int n = 0; n < 2; ++n) acc[a][b][m][n] = (f32x4){0.f, 0.f, 0.f, 0.f};
    bf16x8 At[4][2], B0[2][2], B1[2][2];
    const char* cA = (const char*)g.A + (size_t)cur.pm * tstep; const char* cB = (const char*)g.Bt + (size_t)cur.pn * tstep;
    S.a_ready(cur);
    if constexpr (SP2) {
        PG8_STAGE(PG8_SB(0, 0), cB, voffB); PG8_STAGE(PG8_SB(0, 1), cB + hstep, voffB); PG8_STAGE(PG8_SA(0, 0), cA, voffA); PG8_STAGE(PG8_SA(0, 1), cA + hstep, voffA);
        if (wr == 1) PG8_BAR;
        PG8_WAIT_V(2); PG8_BAR;
        PG8_STAGE(PG8_SB(1, 0), cB + kstep, voffB); PG8_STAGE(PG8_SA(1, 0), cA + kstep, voffA); PG8_STAGE(PG8_SB(1, 1), cB + hstep + kstep, voffB);
        PG8_WAIT_V(6); PG8_BAR;
    } else {
        PG8_STAGE(PG8_SB(0, 0), cB, voffB); PG8_STAGE(PG8_SA(0, 0), cA, voffA); PG8_STAGE(PG8_SB(0, 1), cB + hstep, voffB); PG8_STAGE(PG8_SA(0, 1), cA + hstep, voffA);
        if (wr == 1) PG8_BAR;
        PG8_WAIT_V(4); PG8_BAR;
        PG8_STAGE(PG8_SB(1, 0), cB + kstep, voffB); PG8_STAGE(PG8_SA(1, 0), cA + kstep, voffA); PG8_STAGE(PG8_SB(1, 1), cB + hstep + kstep, voffB);
        PG8_WAIT_V(6); PG8_BAR;
    }
    for (;;) {
        const bool has_next = S.next(ui + 1, nxt);
        const char* nA = has_next ? (const char*)g.A + (size_t)nxt.pm * tstep : cA; const char* nB = has_next ? (const char*)g.Bt + (size_t)nxt.pn * tstep : cB;
        for (int t = 0; t < nt; t += 2) {
            const bool last = (t == nt - 2);
            const char* a1 = cA + (size_t)(t + 1) * kstep;
            const char* a2 = last ? nA : cA + (size_t)(t + 2) * kstep; const char* b2 = last ? nB : cB + (size_t)(t + 2) * kstep;
            const char* a3 = a2 + kstep; const char* b3 = b2 + kstep;
            if (last && has_next) S.a_ready(nxt);
            if constexpr (SP2) {
            PG8_LDB(B0, 0, 0); PG8_LDB(B1, 0, 1); PG8_SCHED; PG8_LDA(At, 0, 0); PG8_STAGE(PG8_SA(1, 1), a1 + hstep, voffA);
            PG8_WAIT_V(8); PG8_WAIT_L(0); PG8_BAR; PG8_MMA(0, 0, At, B0); PG8_MMA(0, 1, At, B1); PG8_BAR; PG8_SCHED;
            PG8_LDA(At, 0, 1); PG8_STAGE(PG8_SB(0, 0), b2, voffB); PG8_STAGE(PG8_SB(0, 1), b2 + hstep, voffB); PG8_STAGE(PG8_SA(0, 0), a2, voffA);
            PG8_WAIT_V(8); PG8_WAIT_L(0); PG8_BAR; PG8_MMA(1, 0, At, B0); PG8_MMA(1, 1, At, B1); PG8_BAR; PG8_SCHED;
            PG8_LDB(B0, 1, 0); PG8_LDB(B1, 1, 1); PG8_SCHED; PG8_LDA(At, 1, 0); PG8_STAGE(PG8_SA(0, 1), a2 + hstep, voffA);
            PG8_WAIT_V(8); PG8_WAIT_L(0); PG8_BAR; PG8_MMA(0, 0, At, B0); PG8_MMA(0, 1, At, B1); PG8_BAR; PG8_SCHED;
            PG8_LDA(At, 1, 1); PG8_STAGE(PG8_SB(1, 0), b3, voffB); PG8_STAGE(PG8_SB(1, 1), b3 + hstep, voffB); PG8_STAGE(PG8_SA(1, 0), a3, voffA);
            PG8_WAIT_V(8); PG8_WAIT_L(0); PG8_BAR; PG8_MMA(1, 0, At, B0); PG8_MMA(1, 1, At, B1); PG8_BAR; PG8_SCHED;
            } else {
            PG8_LDB(B0, 0, 0); PG8_SCHED; PG8_LDA(At, 0, 0); PG8_STAGE(PG8_SA(1, 1), a1 + hstep, voffA);
            PG8_WAIT_L(8); PG8_BAR; PG8_WAIT_L(0); PG8_MMA(0, 0, At, B0); PG8_BAR; PG8_SCHED;
            PG8_LDB(B1, 0, 1); PG8_STAGE(PG8_SB(0, 0), b2, voffB);
            PG8_BAR; PG8_WAIT_L(0); PG8_MMA(0, 1, At, B1); PG8_BAR;
            PG8_LDA(At, 0, 1); PG8_STAGE(PG8_SA(0, 0), a2, voffA);
            PG8_BAR; PG8_WAIT_L(0); PG8_MMA(1, 0, At, B0); PG8_BAR; PG8_SCHED;
            PG8_STAGE(PG8_SB(0, 1), b2 + hstep, voffB);
            PG8_WAIT_V(6); PG8_BAR; PG8_MMA(1, 1, At, B1); PG8_BAR;
            PG8_LDB(B0, 1, 0); PG8_SCHED; PG8_LDA(At, 1, 0); PG8_STAGE(PG8_SA(0, 1), a2 + hstep, voffA);
            PG8_WAIT_L(8); PG8_BAR; PG8_WAIT_L(0); PG8_MMA(0, 0, At, B0); PG8_BAR; PG8_SCHED;
            PG8_LDB(B1, 1, 1); PG8_STAGE(PG8_SB(1, 0), b3, voffB);
            PG8_BAR; PG8_WAIT_L(0); PG8_MMA(0, 1, At, B1); PG8_BAR;
            PG8_LDA(At, 1, 1); PG8_STAGE(PG8_SA(1, 0), a3, voffA);
            PG8_BAR; PG8_WAIT_L(0); PG8_MMA(1, 0, At, B0); PG8_BAR; PG8_SCHED;
            PG8_STAGE(PG8_SB(1, 1), b3 + hstep, voffB);
            PG8_WAIT_V(6); PG8_BAR; PG8_MMA(1, 1, At, B1); PG8_BAR;
            }
        }
        if constexpr (ALIGN_EPI) { if (wr == 0) PG8_BAR; }
        if constexpr (!Epi::AFTER_DRAIN) { E(acc, cur, wr, wc, fr, fq); S.done(cur); }
        if (!has_next) break;
#pragma unroll
        for (int a = 0; a < 2; ++a)
#pragma unroll
            for (int b = 0; b < 2; ++b)
#pragma unroll
                for (int m = 0; m < 4; ++m)
#pragma unroll
                    for (int n = 0; n < 2; ++n) acc[a][b][m][n] = (f32x4){0.f, 0.f, 0.f, 0.f};
        cur = nxt; cA = nA; cB = nB; ++ui;
        if constexpr (ALIGN_EPI) { if (wr == 1) PG8_BAR; }
    }
    PG8_WAIT_V(0);
    if constexpr (!ALIGN_EPI) { if (wr == 0) PG8_BAR; }
    PG8_BAR;
    if constexpr (Epi::AFTER_DRAIN) { E.fused(acc, cur, wr, wc, fr, fq, lds, wid, lane); S.done(cur); }
#undef PG8_SA
#undef PG8_SB
#undef PG8_STAGE
#undef PG8_LDA
#undef PG8_LDB
#undef PG8_MMA
#undef PG8_WAIT_V
#undef PG8_WAIT_L
#undef PG8_BAR
#undef PG8_SCHED
}
}

#define DI __device__ __forceinline__
#define GAS __attribute__((address_space(1)))
#define LAS __attribute__((address_space(3)))
typedef unsigned short bf16;
typedef unsigned v4u __attribute__((ext_vector_type(4)));
typedef unsigned v2u __attribute__((ext_vector_type(2)));
typedef float f32x4 __attribute__((ext_vector_type(4)));
typedef short bf16x8 __attribute__((ext_vector_type(8)));
typedef GAS unsigned gu32;
typedef GAS unsigned long long gu64;
#define RLX_AGENT __ATOMIC_RELAXED, __HIP_MEMORY_SCOPE_AGENT
#define LDS_WAIT() asm volatile("s_waitcnt lgkmcnt(0)" ::: "memory")
#define VM_WAIT() asm volatile("s_waitcnt vmcnt(0)" ::: "memory")

constexpr int NWAVES = 8;
constexpr int DM = 1024, SEQ = 8192, NTOK = 2 * SEQ, RB0 = 128, NROW = NTOK + RB0;
constexpr int A_IN = 2304, B_MAIN = 4096, B_IN = 4112, NCHUNK = 65, NUNIT = 16 * NCHUNK;
constexpr float RMS_EPS = 1e-6f;
#ifndef MK_N_LAUNCHES
#define MK_N_LAUNCHES 1
#endif
constexpr int NPHASE = 10;
constexpr int N_LAUNCHES = MK_N_LAUNCHES;

constexpr size_t MiB = 1u << 20;
constexpr size_t WS_CTL = 0, CTL_ZERO_BYTES = 64 * 1024;
constexpr size_t WS_WA = 1 * MiB, WS_WOA = 6 * MiB, WS_WB = 8 * MiB, WS_WOB = 17 * MiB;
constexpr size_t WS_RSTD0 = 19 * MiB, WS_SSQ1 = 20 * MiB, WS_GATES = 22 * MiB, WS_SSQ2 = 24 * MiB, WS_STAT = 25 * MiB;
constexpr size_t ST_NCHK = 0, ST_MLOC = 512 * 1024, ST_GTOT = 520 * 1024, ST_MPREV = 528 * 1024, ST_NPREV = 544 * 1024;
constexpr size_t WS_RA = 26 * MiB;
constexpr size_t WS_RB = 59 * MiB;
constexpr size_t WS_RC = 92 * MiB;
constexpr size_t WS_K = 125 * MiB, WS_V = 130 * MiB;
constexpr size_t WS_PB = 92 * MiB;
constexpr size_t WS_G = 157 * MiB;
constexpr size_t WS_END = 190 * MiB;
constexpr size_t OUT_CCH = 0, OUT_CPREV = 33 * MiB;
static_assert(WS_WA + (size_t)A_IN * DM * 2 <= WS_WOA && WS_WB + (size_t)B_IN * DM * 2 <= WS_WOB && WS_RA + (size_t)NROW * DM * 2 <= WS_RB && WS_RB + (size_t)NROW * DM * 2 <= WS_RC, "ws map");
static_assert(WS_RC + (size_t)NROW * DM * 2 <= WS_K && WS_K + (size_t)NROW * 256 <= WS_V && WS_V + (size_t)NROW * 256 <= WS_G && WS_PB + (size_t)NROW * 4096 <= WS_G && WS_G + (size_t)NROW * 2048 <= WS_END, "ws map");
static_assert((size_t)NUNIT * 8192 * 4 <= OUT_CPREV && OUT_CPREV + (size_t)NUNIT * 8192 * 2 <= (size_t)NTOK * DM * 4, "d_out scratch map");
constexpr int CW_BAR = 4096;
constexpr int LDS_BYTES = 163840;
constexpr int RING_BYTES = 131072, LDSCTL_OFF = 160 * 1024 - 512, MISC_OFF = LDSCTL_OFF + 320;

DI float bf2f(bf16 b) { return __uint_as_float((unsigned)b << 16); }
DI unsigned f2bf(float f) { unsigned u = __float_as_uint(f); return (u + 0x7fffu + ((u >> 16) & 1u)) >> 16; }
DI unsigned pk2(float lo, float hi) { return f2bf(lo) | (f2bf(hi) << 16); }
DI float blo(unsigned w) { return __uint_as_float(w << 16); }
DI float bhi(unsigned w) { return __uint_as_float(w & 0xffff0000u); }
DI float wave_sum(float v) {
#pragma unroll
    for (int o = 1; o < 64; o <<= 1) v += __shfl_xor(v, o);
    return v;
}
DI float wave_max(float v) {
#pragma unroll
    for (int o = 1; o < 64; o <<= 1) v = fmaxf(v, __shfl_xor(v, o));
    return v;
}
DI float sigmoidf_(float x) { return 1.0f / (1.0f + __expf(-x)); }
DI float siluf_(float x) { return x / (1.0f + __expf(-x)); }
DI float logsigmoidf_(float x) { return fminf(x, 0.f) - __logf(1.0f + __expf(-fabsf(x))); }
DI float dot8(v4u a, v4u b) {
    return blo(a.x) * blo(b.x) + bhi(a.x) * bhi(b.x) + blo(a.y) * blo(b.y) + bhi(a.y) * bhi(b.y) + blo(a.z) * blo(b.z) + bhi(a.z) * bhi(b.z) + blo(a.w) * blo(b.w) + bhi(a.w) * bhi(b.w);
}

constexpr float ROPE_C = 0.41524101186092029f;
DI void rope_pair(float& x1, float& x2, float pos, float inv) {
    const float ang = pos * inv;
    float rev = ang * 0.15915494309189535f; rev = rev - floorf(rev);
    const float s = __builtin_amdgcn_sinf(rev), c = __builtin_amdgcn_cosf(rev);
    const float o1 = x1 * c - x2 * s, o2 = x2 * c + x1 * s; x1 = o1; x2 = o2;
}
struct ADst { bf16* Q; bf16* K; bf16* V; bf16* SZ; };
DI void epiA_quad(f32x4 v, int r, int gcol, float pos, const ADst& d) {
    float a = v[0], b = v[1], c = v[2], e = v[3]; bf16* dst;
    if (gcol < 1152) {
        const int i0 = (gcol & 63) >> 1;
        rope_pair(a, b, pos, __builtin_amdgcn_exp2f(-(float)i0 * ROPE_C)); rope_pair(c, e, pos, __builtin_amdgcn_exp2f(-(float)(i0 + 1) * ROPE_C));
        dst = gcol < 1024 ? d.Q + (size_t)r * DM + gcol : d.K + (size_t)r * 128 + (gcol - 1024);
    } else if (gcol < 1280) dst = d.V + (size_t)r * 128 + (gcol - 1152);
    else { a = siluf_(a); b = siluf_(b); c = siluf_(c); e = siluf_(e); dst = d.SZ + (size_t)r * DM + (gcol - 1280); }
    v2u w; w.x = pg8::cvt_pk_bf16(a, b); w.y = pg8::cvt_pk_bf16(c, e); *(v2u*)dst = w;
}
struct EpiA {
    static constexpr bool PERM = true, AFTER_DRAIN = false;
    ADst d; const float* rstd0;
    DI void operator()(const pg8::f32x4 (&acc)[2][2][4][2], const pg8::Unit& u, int wr, int wc, int fr, int fq) const {
        float rs[2][4];
#pragma unroll
        for (int ai = 0; ai < 2; ++ai)
#pragma unroll
            for (int m = 0; m < 4; ++m) rs[ai][m] = rstd0[RB0 + u.pm * 256 + ai * 128 + wr * 64 + m * 16 + fr];
#pragma unroll
        for (int bj = 0; bj < 2; ++bj) {
            const int gc = u.pn * 256 + bj * 128, gcol = gc + wc * 32 + 8 * fq;
            if (gc < 1152) {
                const int i0 = (gcol & 63) >> 1; float inv[4];
#pragma unroll
                for (int p = 0; p < 4; ++p) inv[p] = __builtin_amdgcn_exp2f(-(float)(i0 + p) * ROPE_C);
                bf16* base = gc < 1024 ? d.Q + gcol : d.K + (gcol - 1024); const int ld = gc < 1024 ? DM : 128;
#pragma unroll
                for (int ai = 0; ai < 2; ++ai)
#pragma unroll
                    for (int m = 0; m < 4; ++m) {
                        const int rt = u.pm * 256 + ai * 128 + wr * 64 + m * 16 + fr; const float pos = (float)(16 + (rt & (SEQ - 1)));
                        f32x4 v0 = acc[ai][bj][m][0] * rs[ai][m], v1 = acc[ai][bj][m][1] * rs[ai][m];
                        float a0 = v0[0], a1 = v0[1], a2 = v0[2], a3 = v0[3], b0 = v1[0], b1 = v1[1], b2 = v1[2], b3 = v1[3];
                        rope_pair(a0, a1, pos, inv[0]); rope_pair(a2, a3, pos, inv[1]); rope_pair(b0, b1, pos, inv[2]); rope_pair(b2, b3, pos, inv[3]);
                        v4u w; w.x = pg8::cvt_pk_bf16(a0, a1); w.y = pg8::cvt_pk_bf16(a2, a3); w.z = pg8::cvt_pk_bf16(b0, b1); w.w = pg8::cvt_pk_bf16(b2, b3);
                        *(v4u*)(base + (size_t)(RB0 + rt) * ld) = w;
                    }
            } else {
                const bool isz = gc >= 1280;
                bf16* base = isz ? d.SZ + (gcol - 1280) : d.V + (gcol - 1152); const int ld = isz ? DM : 128;
#pragma unroll
                for (int ai = 0; ai < 2; ++ai)
#pragma unroll
                    for (int m = 0; m < 4; ++m) {
                        const int rt = u.pm * 256 + ai * 128 + wr * 64 + m * 16 + fr;
                        f32x4 v0 = acc[ai][bj][m][0] * rs[ai][m], v1 = acc[ai][bj][m][1] * rs[ai][m];
                        if (isz) {
#pragma unroll
                            for (int j = 0; j < 4; ++j) { v0[j] = siluf_(v0[j]); v1[j] = siluf_(v1[j]); } }
                        v4u w; w.x = pg8::cvt_pk_bf16(v0[0], v0[1]); w.y = pg8::cvt_pk_bf16(v0[2], v0[3]); w.z = pg8::cvt_pk_bf16(v1[0], v1[1]); w.w = pg8::cvt_pk_bf16(v1[2], v1[3]);
                        *(v4u*)(base + (size_t)(RB0 + rt) * ld) = w;
                    }
            }
        }
    }
};
DI void row_partials_reduce(const float (&ss)[2][4], float* dst  , LAS float* xl, int wr, int wc, int fr, int fq) {
#pragma unroll
    for (int ai = 0; ai < 2; ++ai)
#pragma unroll
        for (int m = 0; m < 4; ++m) if (fq == 0) xl[(ai * 128 + wr * 64 + m * 16 + fr) * 4 + wc] = ss[ai][m];
    asm volatile("s_waitcnt lgkmcnt(0)" ::: "memory"); __builtin_amdgcn_s_barrier(); asm volatile("" ::: "memory");
    const int t = threadIdx.x;
    if (t < 256) { const f32x4 p = *(const LAS f32x4*)(xl + t * 4); dst[t] = (p[0] + p[1]) + (p[2] + p[3]); }
}
struct EpiOutA {
    static constexpr bool PERM = true, AFTER_DRAIN = false;
    const float* x; bf16* H1; float* ssq; LAS float* xl;
    DI void operator()(const pg8::f32x4 (&acc)[2][2][4][2], const pg8::Unit& u, int wr, int wc, int fr, int fq) const {
        float ssv[2][4];
#pragma unroll
        for (int ai = 0; ai < 2; ++ai)
#pragma unroll
            for (int m = 0; m < 4; ++m) {
                const int rt = u.pm * 256 + ai * 128 + wr * 64 + m * 16 + fr; float ss = 0.f;
#pragma unroll
                for (int bj = 0; bj < 2; ++bj) {
                    const int col = u.pn * 256 + bj * 128 + wc * 32 + 8 * fq;
                    const f32x4 x0 = *(const f32x4*)(x + (size_t)rt * DM + col), x1 = *(const f32x4*)(x + (size_t)rt * DM + col + 4);
                    const f32x4 h0 = x0 + acc[ai][bj][m][0], h1 = x1 + acc[ai][bj][m][1];
                    ss += (h0[0] * h0[0] + h0[1] * h0[1]) + (h0[2] * h0[2] + h0[3] * h0[3]) + (h1[0] * h1[0] + h1[1] * h1[1]) + (h1[2] * h1[2] + h1[3] * h1[3]);
                    v4u w; w.x = pg8::cvt_pk_bf16(h0[0], h0[1]); w.y = pg8::cvt_pk_bf16(h0[2], h0[3]); w.z = pg8::cvt_pk_bf16(h1[0], h1[1]); w.w = pg8::cvt_pk_bf16(h1[2], h1[3]);
                    *(v4u*)(H1 + (size_t)(RB0 + rt) * DM + col) = w;
                }
                ss += __shfl_xor(ss, 16); ss += __shfl_xor(ss, 32); ssv[ai][m] = ss;
            }
        row_partials_reduce(ssv, ssq + (size_t)u.pn * NROW + RB0 + u.pm * 256, xl, wr, wc, fr, fq);
    }
};
DI float rstd_from4(const float* ssq, int stride, int r) {
    const float s = (ssq[r] + ssq[(size_t)stride + r]) + (ssq[(size_t)2 * stride + r] + ssq[(size_t)3 * stride + r]);
    return 1.0f / sqrtf(s * (1.0f / DM) + RMS_EPS);
}
DI float rstd_from16(const float* ssq, int stride, int r) {
    float s = 0.f;
#pragma unroll
    for (int p = 0; p < 16; ++p) s += ssq[(size_t)p * stride + r];
    return 1.0f / sqrtf(s * (1.0f / DM) + RMS_EPS);
}
DI float gate_oz(float o, float z) { return z / ((1.0f + __expf(-o)) * (1.0f + __expf(-z))); }
DI void epiB_quad(f32x4 v, int r, int gcol, bf16* PB, bf16* G) {
    if (gcol < 2048) { v2u w; w.x = pg8::cvt_pk_bf16(v[0], v[1]); w.y = pg8::cvt_pk_bf16(v[2], v[3]); *(v2u*)(PB + (size_t)r * 2048 + gcol) = w; }
    else { *(unsigned*)(G + (size_t)r * DM + ((gcol - 2048) >> 1)) = pg8::cvt_pk_bf16(gate_oz(v[0], v[1]), gate_oz(v[2], v[3])); }
}
struct EpiB {
    static constexpr bool PERM = true, AFTER_DRAIN = false;
    const float* ssq1; bf16* PB; bf16* G;
    DI void operator()(const pg8::f32x4 (&acc)[2][2][4][2], const pg8::Unit& u, int wr, int wc, int fr, int fq) const {
#pragma unroll
        for (int ai = 0; ai < 2; ++ai)
#pragma unroll
            for (int m = 0; m < 4; ++m) {
                const int r = RB0 + u.pm * 256 + ai * 128 + wr * 64 + m * 16 + fr;
                const float rs = rstd_from4(ssq1, NROW, r);
#pragma unroll
                for (int bj = 0; bj < 2; ++bj) {
                    const int gc = u.pn * 256 + bj * 128, gcol = gc + wc * 32 + 8 * fq;
                    const f32x4 v0 = acc[ai][bj][m][0] * rs, v1 = acc[ai][bj][m][1] * rs;
                    if (gc < 2048) {
                        v4u w; w.x = pg8::cvt_pk_bf16(v0[0], v0[1]); w.y = pg8::cvt_pk_bf16(v0[2], v0[3]); w.z = pg8::cvt_pk_bf16(v1[0], v1[1]); w.w = pg8::cvt_pk_bf16(v1[2], v1[3]);
                        *(v4u*)(PB + (size_t)r * 2048 + gcol) = w;
                    } else {
                        v2u w; w.x = pg8::cvt_pk_bf16(gate_oz(v0[0], v0[1]), gate_oz(v0[2], v0[3])); w.y = pg8::cvt_pk_bf16(gate_oz(v1[0], v1[1]), gate_oz(v1[2], v1[3]));
                        *(v2u*)(G + (size_t)r * DM + ((gcol - 2048) >> 1)) = w;
                    }
                }
            }
    }
};
struct EpiOutB {
    static constexpr bool PERM = true, AFTER_DRAIN = false;
    const bf16* H1; float* out; float* ssq; LAS float* xl;
    DI void operator()(const pg8::f32x4 (&acc)[2][2][4][2], const pg8::Unit& u, int wr, int wc, int fr, int fq) const {
        float ssv[2][4];
#pragma unroll
        for (int ai = 0; ai < 2; ++ai)
#pragma unroll
            for (int m = 0; m < 4; ++m) {
                const int rt = u.pm * 256 + ai * 128 + wr * 64 + m * 16 + fr; float ss = 0.f;
#pragma unroll
                for (int bj = 0; bj < 2; ++bj) {
                    const int col = u.pn * 256 + bj * 128 + wc * 32 + 8 * fq;
                    const v4u hw = *(const v4u*)(H1 + (size_t)(RB0 + rt) * DM + col);
                    f32x4 h0 = acc[ai][bj][m][0], h1 = acc[ai][bj][m][1];
                    h0[0] += blo(hw.x); h0[1] += bhi(hw.x); h0[2] += blo(hw.y); h0[3] += bhi(hw.y); h1[0] += blo(hw.z); h1[1] += bhi(hw.z); h1[2] += blo(hw.w); h1[3] += bhi(hw.w);
                    ss += (h0[0] * h0[0] + h0[1] * h0[1]) + (h0[2] * h0[2] + h0[3] * h0[3]) + (h1[0] * h1[0] + h1[1] * h1[1]) + (h1[2] * h1[2] + h1[3] * h1[3]);
                    *(f32x4*)(out + (size_t)rt * DM + col) = h0; *(f32x4*)(out + (size_t)rt * DM + col + 4) = h1;
                }
                ss += __shfl_xor(ss, 16); ss += __shfl_xor(ss, 32); ssv[ai][m] = ss;
            }
        row_partials_reduce(ssv, ssq + (size_t)u.pn * NTOK + u.pm * 256, xl, wr, wc, fr, fq);
    }
};

DI f32x4 thin_tile(const bf16* A, const bf16* Wt, int lane) {
    const bf16* ap = A + (size_t)(lane & 15) * DM + 8 * (lane >> 4);
    const bf16* bp = Wt + (size_t)(lane & 15) * DM + 8 * (lane >> 4);
    f32x4 acc = (f32x4){0.f, 0.f, 0.f, 0.f};
#pragma unroll 8
    for (int k0 = 0; k0 < DM; k0 += 32) {
        const bf16x8 a = *(const bf16x8*)(ap + k0), b = *(const bf16x8*)(bp + k0);
        acc = __builtin_amdgcn_mfma_f32_16x16x32_bf16(b, a, acc, 0, 0, 0);
    }
    return acc;
}

struct Frame {
    LAS unsigned char* lds;
    volatile LAS unsigned* MISC;
    gu32* ctl;
    int tid, lane, wave, G;
    const float *x, *meta, *norm_a, *w_in_a, *sinks, *w_out_a, *norm_b, *w_in_b, *b_gates, *w_out_b, *norm_f; float* out;
    bf16 *WA, *WOA, *WB, *WOB;
    float *RSTD0, *SSQ1, *SSQM, *GATES, *SSQ2, *NCHK, *MLOC, *GTOT, *MPREV, *NPREV, *CCH;
    bf16 *XB, *YA, *YB, *Q, *H1, *SZ, *K, *V, *PB, *GG, *CPREV;
};

struct ColMapA {
    DI int col(int n) const { if (n < 1152) { const int hd = n >> 6, j = n & 63; return hd * 64 + (j >> 1) + 32 * (j & 1); } return n; }
    DI float scale(int) const { return 1.f; }
};
struct ColMapB {
    DI int col(int n) const { if (n >= 2048 && n < 4096) { const int j = (n - 2048) >> 1, e = n & 1; return 2048 + j + 1024 * e; } return n; }
    DI float scale(int n) const { return (n >= 512 && n < 1024) ? 0.125f : 1.f; }
};
struct ColMapId { DI int col(int n) const { return n; } DI float scale(int) const { return 1.f; } };
template <class CM>
DI void p0_item(const float* W, int K, int Nsrc, int Ndst, bf16* WT, const float* gain, LAS float* scr, int item, int lane, CM cm) {
    const int nblk = (Ndst + 31) / 32, kb = item / nblk, nb = item % nblk, k0 = 64 * kb, n0 = 32 * nb;
    const int nn = n0 + (lane & 31); const bool okc = nn < Ndst; const int src = okc ? cm.col(nn) : 0; const float sc = cm.scale(nn);
#pragma unroll 8
    for (int i = 0; i < 32; ++i) { const int kk = 2 * i + (lane >> 5); float v = 0.f;
        if (okc) { v = W[(size_t)(k0 + kk) * Nsrc + src] * sc; if (gain) v *= gain[k0 + kk]; }
        scr[kk * 33 + (lane & 31)] = v; }
    LDS_WAIT(); asm volatile("" ::: "memory");
    const int c = lane & 7;
#pragma unroll
    for (int j = 0; j < 4; ++j) { const int n = (lane >> 3) + 8 * j; const LAS float* s = scr + (8 * c) * 33 + n;
        v4u o; o.x = pk2(s[0 * 33], s[1 * 33]); o.y = pk2(s[2 * 33], s[3 * 33]); o.z = pk2(s[4 * 33], s[5 * 33]); o.w = pk2(s[6 * 33], s[7 * 33]);
        if (n0 + n < Ndst) *(GAS v4u*)(WT + (size_t)(n0 + n) * K + k0 + 8 * c) = o; }
    LDS_WAIT(); asm volatile("" ::: "memory");
}
DI void p0_row(const float* src, bf16* dst, float* rstd_out, int lane) {
    const GAS f32x4* xr = (const GAS f32x4*)src + lane;
    f32x4 v[4]; float s = 0.f;
#pragma unroll
    for (int j = 0; j < 4; ++j) { v[j] = xr[64 * j]; s += (v[j].x * v[j].x + v[j].y * v[j].y) + (v[j].z * v[j].z + v[j].w * v[j].w); }
    s = wave_sum(s);
    GAS v2u* o8 = (GAS v2u*)dst + lane;
#pragma unroll
    for (int j = 0; j < 4; ++j) { v2u w; w.x = pk2(v[j].x, v[j].y); w.y = pk2(v[j].z, v[j].w); o8[64 * j] = w; }
    if (lane == 0) *rstd_out = 1.0f / sqrtf(s * (1.0f / DM) + RMS_EPS);
}
DI void p0_prologue(Frame& F) {
    LAS float* scr = (LAS float*)(F.lds + F.wave * 16384);
    const int gw = blockIdx.x * NWAVES + F.wave, NGW = F.G * NWAVES;
    constexpr int I_A = 16 * 72, I_OA = 16 * 32, I_B = 16 * 129, I_OB = 16 * 32;
    for (int it = gw; it < I_A + I_OA + I_B + I_OB; it += NGW) {
        int r = it;
        if (r < I_A) { p0_item(F.w_in_a, DM, A_IN, A_IN, F.WA, F.norm_a, scr, r, F.lane, ColMapA()); continue; } r -= I_A;
        if (r < I_OA) { p0_item(F.w_out_a, DM, DM, DM, F.WOA, (const float*)nullptr, scr, r, F.lane, ColMapId()); continue; } r -= I_OA;
        if (r < I_B) { p0_item(F.w_in_b, DM, B_IN, B_IN, F.WB, F.norm_b, scr, r, F.lane, ColMapB()); continue; } r -= I_B;
        p0_item(F.w_out_b, DM, DM, DM, F.WOB, (const float*)nullptr, scr, r, F.lane, ColMapId());
    }
    for (int m = gw; m < 16 + NTOK; m += NGW) {
        if (m < 16) p0_row(F.meta + (size_t)m * DM, F.XB + (size_t)(112 + m) * DM, F.RSTD0 + 112 + m, F.lane);
        else p0_row(F.x + (size_t)(m - 16) * DM, F.XB + (size_t)(RB0 + m - 16) * DM, F.RSTD0 + RB0 + m - 16, F.lane);
    }
    const int gt = blockIdx.x * (NWAVES * 64) + F.tid;
    if (gt < 112 * 128 * 2 / 16) { ((v4u*)F.K)[gt] = (v4u){0u, 0u, 0u, 0u}; ((v4u*)F.V)[gt] = (v4u){0u, 0u, 0u, 0u}; }
}

DI void phase_inproj_a(Frame& F) {
    const ADst d{F.Q, F.K, F.V, F.SZ};
    { const int gw = blockIdx.x * NWAVES + F.wave;
      if (gw < A_IN / 16) {
          const f32x4 acc = thin_tile(F.XB + (size_t)112 * DM, F.WA + (size_t)gw * 16 * DM, F.lane);
          const int row = 112 + (F.lane & 15);
          epiA_quad(acc * F.RSTD0[row], row, 16 * gw + 4 * (F.lane >> 4), (float)(F.lane & 15), d);
      } }
    pg8::Gemm g{F.XB + (size_t)RB0 * DM, F.WA, NTOK, A_IN, DM}; pg8::StaticOrder S; S.init(NTOK, A_IN, F.G, (int)blockIdx.x);
    EpiA E{d, F.RSTD0};
    pg8::gemm_phase<EpiA, pg8::StaticOrder, true, true>(F.lds, g, S, E);
}

DI void phase_attn_naive(Frame& F) {
    const int gw = blockIdx.x * NWAVES + F.wave, NGW = F.G * NWAVES, lane = F.lane;
    for (int task = gw; task < (16 + NTOK) * 16; task += NGW) {
        const int head = task & 15, qi = task >> 4, kvh = head >> 3;
        int r, b, p;
        if (qi < 16) { r = 112 + qi; b = 0; p = r; } else { const int tok = qi - 16; b = tok >> 13; p = RB0 + (tok & (SEQ - 1)); r = RB0 + tok; }
        const bf16* qp = F.Q + (size_t)r * DM + head * 64;
        float s[2];
#pragma unroll
        for (int jj = 0; jj < 2; ++jj) {
            const int pk = p - 127 + lane + 64 * jj; const bool valid = pk >= 112; const int kr = valid ? (pk < RB0 ? pk : b * SEQ + pk) : 112;
            const bf16* kp = F.K + (size_t)kr * 128 + kvh * 64; float a = 0.f;
#pragma unroll
            for (int c = 0; c < 8; ++c) a += dot8(*(const v4u*)(qp + 8 * c), *(const v4u*)(kp + 8 * c));
            s[jj] = valid ? a * 0.125f : -INFINITY;
        }
        const float sink = F.sinks[head];
        const float m = fmaxf(wave_max(fmaxf(s[0], s[1])), sink);
        const float p0 = __expf(s[0] - m), p1 = __expf(s[1] - m);
        const float l = wave_sum(p0 + p1) + __expf(sink - m);
        float o = 0.f;
        for (int j = 0; j < 64; ++j) { const int pk = p - 127 + j; const float pj = __shfl(p0, j);
            if (pk >= 112) { const int kr = pk < RB0 ? pk : b * SEQ + pk; o += pj * bf2f(F.V[(size_t)kr * 128 + kvh * 64 + lane]); } }
        for (int j = 0; j < 64; ++j) { const int pk = p - 63 + j; const float pj = __shfl(p1, j);
            if (pk >= 112) { const int kr = pk < RB0 ? pk : b * SEQ + pk; o += pj * bf2f(F.V[(size_t)kr * 128 + kvh * 64 + lane]); } }
        o /= l;
        const size_t oi = (size_t)r * DM + head * 64 + lane;
        F.YA[oi] = (bf16)f2bf(o * bf2f(F.SZ[oi]));
    }
}

DI void phase_outproj_a(Frame& F) {
    { const int gw = blockIdx.x * NWAVES + F.wave;
      if (gw < 16) {
          const int row = 112 + (F.lane & 15); float ss = 0.f;
#pragma unroll
          for (int tt = 0; tt < 4; ++tt) {
              const f32x4 acc = thin_tile(F.YA + (size_t)112 * DM, F.WOA + (size_t)(gw * 64 + tt * 16) * DM, F.lane);
              const int col = gw * 64 + tt * 16 + 4 * (F.lane >> 4);
              const f32x4 h = *(const f32x4*)(F.meta + (size_t)(row - 112) * DM + col) + acc;
              ss += (h[0] * h[0] + h[1] * h[1]) + (h[2] * h[2] + h[3] * h[3]);
              v2u w; w.x = pg8::cvt_pk_bf16(h[0], h[1]); w.y = pg8::cvt_pk_bf16(h[2], h[3]); *(v2u*)(F.H1 + (size_t)row * DM + col) = w;
          }
          ss += __shfl_xor(ss, 16); ss += __shfl_xor(ss, 32);
          if (F.lane < 16) F.SSQM[gw * 16 + F.lane] = ss;
      } }
    pg8::Gemm g{F.YA + (size_t)RB0 * DM, F.WOA, NTOK, DM, DM}; pg8::StaticOrder S; S.init(NTOK, DM, F.G, (int)blockIdx.x);
    EpiOutA E{F.x, F.H1, F.SSQ1, (LAS float*)(F.lds + RING_BYTES)};
    pg8::gemm_phase<EpiOutA, pg8::StaticOrder, true, true>(F.lds, g, S, E);
}

DI void phase_inproj_b(Frame& F) {
    { const int gw = blockIdx.x * NWAVES + F.wave, NGW = F.G * NWAVES;
      for (int task = gw; task < 257 + NTOK / 16; task += NGW) {
          const int rowbase = task <= 256 ? 112 : RB0 + (task - 257) * 16, ntile = task < 256 ? task : 256;
          const f32x4 acc = thin_tile(F.H1 + (size_t)rowbase * DM, F.WB + (size_t)ntile * 16 * DM, F.lane);
          const int row = rowbase + (F.lane & 15), n4 = 4 * (F.lane >> 4);
          const float rs = task <= 256 ? rstd_from16(F.SSQM, 16, F.lane & 15) : rstd_from4(F.SSQ1, NROW, row);
          if (ntile < 256) epiB_quad(acc * rs, row, ntile * 16 + n4, F.PB, F.GG);
          else { const f32x4 bg = *(const f32x4*)(F.b_gates + n4); *(f32x4*)(F.GATES + (size_t)row * 16 + n4) = acc * rs + bg; }
      } }
    pg8::Gemm g{F.H1 + (size_t)RB0 * DM, F.WB, NTOK, B_MAIN, DM}; pg8::StaticOrder S; S.init(NTOK, B_MAIN, F.G, (int)blockIdx.x);
    EpiB E{F.SSQ1, F.PB, F.GG};
    pg8::gemm_phase<EpiB, pg8::StaticOrder, true, true>(F.lds, g, S, E);
}

DI int chunk_row0(int b, int n) { return n == 0 ? 0 : RB0 + b * SEQ + (n - 1) * 128; }
DI void phase_chunk_naive(Frame& F) {
    LAS bf16* KT = (LAS bf16*)(F.lds);
    LAS bf16* VT = (LAS bf16*)(F.lds + 16384);
    LAS float* SA = (LAS float*)(F.lds + 49152);
    const int tid = F.tid;
    for (int u = blockIdx.x; u < NUNIT; u += F.G) {
        const int bh = u / NCHUNK, n = u % NCHUNK, b = bh >> 3, h = bh & 7, row0 = chunk_row0(b, n);
        for (int c = tid; c < 1024; c += 512) { const int t = c >> 3, ch = c & 7; *(LAS v4u*)(KT + t * 64 + ch * 8) = *(const v4u*)(F.PB + (size_t)(row0 + t) * 2048 + 512 + h * 64 + ch * 8); }
        for (int c = tid; c < 2048; c += 512) { const int t = c >> 4, ch = c & 15; *(LAS v4u*)(VT + t * 128 + ch * 8) = *(const v4u*)(F.PB + (size_t)(row0 + t) * 2048 + 1024 + h * 128 + ch * 8); }
        if (tid < 128) { const bool valid = (n > 0) || (tid >= 112); const float* gp = F.GATES + (size_t)(row0 + tid) * 16;
            SA[tid] = valid ? logsigmoidf_(gp[8 + h]) : 0.f; SA[128 + tid] = valid ? gp[h] : -INFINITY; }
        __syncthreads();
        if (tid == 0) { float bs = 0.f; for (int t = 0; t < 128; ++t) { bs += SA[t]; SA[256 + t] = bs; } SA[512] = bs; }
        __syncthreads();
        const float g = SA[512];
        if (tid < 64) { const float a0 = g - SA[256 + tid] + SA[128 + tid], a1 = g - SA[256 + 64 + tid] + SA[128 + 64 + tid];
            const float ml = wave_max(fmaxf(a0, a1)); SA[384 + tid] = __expf(a0 - ml); SA[384 + 64 + tid] = __expf(a1 - ml); if (tid == 0) SA[513] = ml; }
        __syncthreads();
        { const int v = tid & 127, kg = tid >> 7; float acc[16];
#pragma unroll
          for (int kk = 0; kk < 16; ++kk) acc[kk] = 0.f;
          for (int t = 0; t < 128; ++t) { const float wv = SA[384 + t] * bf2f(VT[t * 128 + v]);
              const v4u k0 = *(const LAS v4u*)(KT + t * 64 + kg * 16), k1 = *(const LAS v4u*)(KT + t * 64 + kg * 16 + 8);
              acc[0] += wv * blo(k0.x); acc[1] += wv * bhi(k0.x); acc[2] += wv * blo(k0.y); acc[3] += wv * bhi(k0.y); acc[4] += wv * blo(k0.z); acc[5] += wv * bhi(k0.z); acc[6] += wv * blo(k0.w); acc[7] += wv * bhi(k0.w);
              acc[8] += wv * blo(k1.x); acc[9] += wv * bhi(k1.x); acc[10] += wv * blo(k1.y); acc[11] += wv * bhi(k1.y); acc[12] += wv * blo(k1.z); acc[13] += wv * bhi(k1.z); acc[14] += wv * blo(k1.w); acc[15] += wv * bhi(k1.w); }
          float* cp = F.CCH + (size_t)u * 8192 + v * 64 + kg * 16;
#pragma unroll
          for (int q = 0; q < 4; ++q) *(f32x4*)(cp + 4 * q) = (f32x4){acc[4 * q], acc[4 * q + 1], acc[4 * q + 2], acc[4 * q + 3]}; }
        if (tid < 64) { float a = 0.f; for (int t = 0; t < 128; ++t) a += SA[384 + t] * bf2f(KT[t * 64 + tid]); F.NCHK[(size_t)u * 64 + tid] = a; }
        if (tid == 0) { F.MLOC[u] = SA[513]; F.GTOT[u] = g; }
        __syncthreads();
    }
}

DI void phase_scan(Frame& F) {
    const int gid = blockIdx.x * (NWAVES * 64) + F.tid, NG = F.G * NWAVES * 64;
    for (int e = gid; e < 16 * 8192 + 16 * 64; e += NG) {
        const bool isn = e >= 16 * 8192; const int ee = isn ? e - 16 * 8192 : e;
        const int bh = isn ? ee >> 6 : ee >> 13, idx = isn ? ee & 63 : ee & 8191;
        const float* src = isn ? F.NCHK + (size_t)bh * NCHUNK * 64 + idx : F.CCH + (size_t)bh * NCHUNK * 8192 + idx; const int sstr = isn ? 64 : 8192;
        float c = 0.f, m = 0.f;
        for (int n0 = 0; n0 < NCHUNK; n0 += 13) {
            float cc[13];
#pragma unroll
            for (int i = 0; i < 13; ++i) cc[i] = src[(size_t)(n0 + i) * sstr];
#pragma unroll
            for (int i = 0; i < 13; ++i) {
                const int u = bh * NCHUNK + n0 + i; const float g = F.GTOT[u], ml = F.MLOC[u];
                if (isn) F.NPREV[(size_t)u * 64 + idx] = c; else { F.CPREV[(size_t)u * 8192 + idx] = (bf16)f2bf(c); if (idx == 0) F.MPREV[u] = m; }
                const float mn = fmaxf(g + m, ml), dec = __expf(g + m - mn), inj = __expf(ml - mn);
                c = dec * c + inj * cc[i]; m = mn;
            }
        }
    }
}

DI void phase_mlstm_out_naive(Frame& F) {
    LAS bf16* QT = (LAS bf16*)(F.lds);
    LAS bf16* KT = (LAS bf16*)(F.lds + 16384);
    LAS bf16* CP = (LAS bf16*)(F.lds + 32768);
    LAS bf16* VT = (LAS bf16*)(F.lds + 49152);
    LAS float* AT = (LAS float*)(F.lds + 81920);
    LAS float* SA = (LAS float*)(F.lds + 147456);
    const int tid = F.tid;
    for (int unit = blockIdx.x; unit < 16 * 64; unit += F.G) {
        const int bh = unit >> 6, n = 1 + (unit & 63), b = bh >> 3, h = bh & 7, u = bh * NCHUNK + n, row0 = chunk_row0(b, n);
        for (int c = tid; c < 1024; c += 512) { const int t = c >> 3, ch = c & 7; const bf16* rp = F.PB + (size_t)(row0 + t) * 2048 + h * 64 + ch * 8;
            *(LAS v4u*)(QT + t * 64 + ch * 8) = *(const v4u*)rp; *(LAS v4u*)(KT + t * 64 + ch * 8) = *(const v4u*)(rp + 512);
            *(LAS v4u*)(CP + c * 8) = *(const v4u*)(F.CPREV + (size_t)u * 8192 + c * 8); }
        for (int c = tid; c < 2048; c += 512) { const int t = c >> 4, ch = c & 15; *(LAS v4u*)(VT + t * 128 + ch * 8) = *(const v4u*)(F.PB + (size_t)(row0 + t) * 2048 + 1024 + h * 128 + ch * 8); }
        if (tid < 128) { const float* gp = F.GATES + (size_t)(row0 + tid) * 16; SA[tid] = logsigmoidf_(gp[8 + h]); SA[128 + tid] = gp[h]; }
        if (tid < 64) SA[896 + tid] = F.NPREV[(size_t)u * 64 + tid];
        __syncthreads();
        if (tid == 0) { const float mp = F.MPREV[u]; float bs = 0.f, pm = -INFINITY;
            for (int t = 0; t < 128; ++t) { bs += SA[t]; const float us = SA[128 + t] - bs; pm = fmaxf(pm, us); const float inter = bs + mp, mt = fmaxf(inter, bs + pm);
                SA[256 + t] = bs; SA[384 + t] = us; SA[512 + t] = mt; SA[640 + t] = __expf(inter - mt); } }
        __syncthreads();
#pragma unroll 1
        for (int i = 0; i < 32; ++i) { const int id = tid + 512 * i, t = id >> 7, s = id & 127; float val = 0.f;
            if (s <= t) { float d = 0.f;
#pragma unroll
                for (int c = 0; c < 8; ++c) d += dot8(*(const LAS v4u*)(QT + t * 64 + c * 8), *(const LAS v4u*)(KT + s * 64 + c * 8));
                val = __expf(SA[256 + t] + SA[384 + s] - SA[512 + t]) * d; }
            AT[t * 128 + s] = val; }
        __syncthreads();
        if (tid < 128) { const int t = tid; float qn = 0.f, rsum = 0.f;
            for (int k = 0; k < 64; ++k) qn += bf2f(QT[t * 64 + k]) * SA[896 + k];
            for (int s = 0; s <= t; ++s) rsum += AT[t * 128 + s];
            SA[768 + t] = SA[640 + t] * qn + rsum; }
        __syncthreads();
        { const int v = tid & 127, tg = tid >> 7;
#pragma unroll 1
          for (int t = tg * 32; t < tg * 32 + 32; ++t) {
              float acc = 0.f;
#pragma unroll
              for (int c = 0; c < 8; ++c) acc += dot8(*(const LAS v4u*)(QT + t * 64 + c * 8), *(const LAS v4u*)(CP + v * 64 + c * 8));
              acc *= SA[640 + t];
              for (int s = 0; s <= t; ++s) acc += AT[t * 128 + s] * bf2f(VT[s * 128 + v]);
              const float hc = acc / fmaxf(fabsf(SA[768 + t]), __expf(-SA[512 + t]));
              const size_t oi = (size_t)(row0 + t) * DM + h * 128 + v;
              F.YB[oi] = (bf16)f2bf(hc * bf2f(F.GG[oi]));
          } }
        __syncthreads();
    }
}

DI void phase_outproj_b(Frame& F) {
    pg8::Gemm g{F.YB + (size_t)RB0 * DM, F.WOB, NTOK, DM, DM}; pg8::StaticOrder S; S.init(NTOK, DM, F.G, (int)blockIdx.x);
    EpiOutB E{F.H1, F.out, F.SSQ2, (LAS float*)(F.lds + RING_BYTES)};
    pg8::gemm_phase<EpiOutB, pg8::StaticOrder, true, true>(F.lds, g, S, E);
}
DI void phase_final_norm(Frame& F) {
    const int gw = blockIdx.x * NWAVES + F.wave, NGW = F.G * NWAVES;
    f32x4 gn[4];
#pragma unroll
    for (int j = 0; j < 4; ++j) gn[j] = ((const f32x4*)F.norm_f)[F.lane + 64 * j];
    for (int m = gw; m < NTOK; m += NGW) {
        const float rs = rstd_from4(F.SSQ2, NTOK, m);
        GAS f32x4* o = (GAS f32x4*)(F.out + (size_t)m * DM) + F.lane;
#pragma unroll
        for (int j = 0; j < 4; ++j) o[64 * j] = o[64 * j] * rs * gn[j];
    }
}
#define XB_TMO      128
#define XB_XCNT(j)  (256  + 64 * (j))
#define XB_XSUB(j)  (1280 + 64 * (j))
#define XB_XGEN(j)  (2304 + 64 * (j))
#define XB_TOP      3328
#define XB_TOPGEN   3392
#define XCD_BAR_WORDS 3456
#define XB_SPIN_CAP (1u << 18)

__device__ __forceinline__ unsigned xb_ld(unsigned* p)              { return __hip_atomic_load(p, __ATOMIC_RELAXED, __HIP_MEMORY_SCOPE_AGENT); }
__device__ __forceinline__ unsigned xb_add(unsigned* p, unsigned v) { return __hip_atomic_fetch_add(p, v, __ATOMIC_RELAXED, __HIP_MEMORY_SCOPE_AGENT); }
__device__ __forceinline__ unsigned xb_xcc_id() { return (unsigned)__builtin_amdgcn_s_getreg((3 << 11) | 20) & 0xFu; }
#define XB_SPIN(cond, bar) do { unsigned _sp = 0; while (cond) { __builtin_amdgcn_s_sleep(1); \
    if ((++_sp & 255u) == 0u) { if (xb_ld(&(bar)[XB_TMO])) break; if (_sp > XB_SPIN_CAP) { atomicAdd(&(bar)[XB_TMO], 1u); break; } } } } while (0)

struct XcdBarrier {
    unsigned* bar; unsigned x;
    volatile LAS unsigned* st;
};

__device__ __forceinline__ XcdBarrier xcd_barrier_post(unsigned* bar, volatile LAS unsigned* st) {
    XcdBarrier b; b.bar = bar; b.x = xb_xcc_id(); b.st = st;
    if (threadIdx.x == 0) (void)xb_add(&bar[XB_XCNT(b.x)], 1u);
    return b;
}
__device__ __forceinline__ void xcd_barrier_complete(unsigned* bar, unsigned x, unsigned& nloc, unsigned& nx) {
    const unsigned G = gridDim.x * gridDim.y * gridDim.z;
    unsigned sum, cnt, mine, sp = 0u;
    for (;;) {
        sum = 0u; cnt = 0u; mine = 0u;
#pragma unroll
        for (unsigned j = 0; j < 16; ++j) { const unsigned c = xb_ld(&bar[XB_XCNT(j)]); sum += c; cnt += (c > 0u) ? 1u : 0u; mine = (j == x) ? c : mine; }
        if (sum == G) break;
        __builtin_amdgcn_s_sleep(1);
        if ((++sp & 255u) == 0u) { if (xb_ld(&bar[XB_TMO])) break; if (sp > XB_SPIN_CAP) { atomicAdd(&bar[XB_TMO], 1u); break; } }
    }
    nloc = mine > 0u ? mine : 1u; nx = cnt > 0u ? cnt : 1u;
}

__device__ __forceinline__ void xcd_barrier(const XcdBarrier& b) {
    asm volatile("s_waitcnt vmcnt(0)" ::: "memory");
    __syncthreads();
    if (threadIdx.x == 0) {
        unsigned* bar = b.bar;
        __builtin_amdgcn_s_waitcnt(0);
        unsigned nloc = b.st[0], nx = b.st[1];
        if (nloc == 0u) { xcd_barrier_complete(bar, b.x, nloc, nx); b.st[0] = nloc; b.st[1] = nx; }
        const unsigned old = xb_add(&bar[XB_XSUB(b.x)], 1u);
        const unsigned gen = old / nloc;
        if (old + 1u == (gen + 1u) * nloc) {
            __builtin_amdgcn_fence(__ATOMIC_RELEASE, "agent");
            asm volatile("s_waitcnt vmcnt(0)" ::: "memory");
            const unsigned og = xb_add(&bar[XB_TOP], 1u);
            const unsigned tg = og / nx;
            if (og + 1u == (tg + 1u) * nx) xb_add(&bar[XB_TOPGEN], 1u);
            else XB_SPIN(xb_ld(&bar[XB_TOPGEN]) == tg, bar);
            __builtin_amdgcn_fence(__ATOMIC_ACQUIRE, "agent");
            xb_add(&bar[XB_XGEN(b.x)], 1u);
            asm volatile("s_waitcnt vmcnt(0)" ::: "memory");
        } else {
            XB_SPIN(xb_ld(&bar[XB_XGEN(b.x)]) == gen, bar);
            __builtin_amdgcn_fence(__ATOMIC_ACQUIRE, "agent");
            asm volatile("s_waitcnt vmcnt(0)" ::: "memory");
        }
    }
    __syncthreads();
}

#ifndef PHASE_MASK
#define PHASE_MASK 0x3ff
#endif
struct Args { const float* in[11]; float* out; unsigned char* ws; int ph_lo, ph_hi; };
__global__ void __launch_bounds__(NWAVES * 64, 2) fwd_kernel(Args args) {
    extern __shared__ __attribute__((aligned(16))) unsigned char lds[];
    Frame F;
    F.lds = (LAS unsigned char*)lds;
    F.MISC = (volatile LAS unsigned*)(F.lds + MISC_OFF);
    F.tid = threadIdx.x; F.lane = F.tid & 63; F.wave = __builtin_amdgcn_readfirstlane(F.tid >> 6);
    F.G = gridDim.x;
    unsigned char* ws = args.ws;
    F.ctl = (gu32*)(ws + WS_CTL);
    F.x = args.in[0]; F.meta = args.in[1]; F.norm_a = args.in[2]; F.w_in_a = args.in[3]; F.sinks = args.in[4]; F.w_out_a = args.in[5];
    F.norm_b = args.in[6]; F.w_in_b = args.in[7]; F.b_gates = args.in[8]; F.w_out_b = args.in[9]; F.norm_f = args.in[10]; F.out = args.out;
    F.WA = (bf16*)(ws + WS_WA); F.WOA = (bf16*)(ws + WS_WOA); F.WB = (bf16*)(ws + WS_WB); F.WOB = (bf16*)(ws + WS_WOB);
    F.RSTD0 = (float*)(ws + WS_RSTD0); F.SSQ1 = (float*)(ws + WS_SSQ1); F.SSQM = (float*)(ws + WS_SSQ1 + MiB); F.GATES = (float*)(ws + WS_GATES); F.SSQ2 = (float*)(ws + WS_SSQ2);
    F.NCHK = (float*)(ws + WS_STAT + ST_NCHK); F.MLOC = (float*)(ws + WS_STAT + ST_MLOC); F.GTOT = (float*)(ws + WS_STAT + ST_GTOT);
    F.MPREV = (float*)(ws + WS_STAT + ST_MPREV); F.NPREV = (float*)(ws + WS_STAT + ST_NPREV);
    F.XB = (bf16*)(ws + WS_RA); F.YA = F.XB; F.YB = F.XB; F.Q = (bf16*)(ws + WS_RB); F.H1 = F.Q; F.SZ = (bf16*)(ws + WS_RC);
    F.K = (bf16*)(ws + WS_K); F.V = (bf16*)(ws + WS_V); F.PB = (bf16*)(ws + WS_PB); F.GG = (bf16*)(ws + WS_G);
    F.CCH = (float*)((unsigned char*)args.out + OUT_CCH); F.CPREV = (bf16*)((unsigned char*)args.out + OUT_CPREV);
    for (int u = F.tid; u < (LDS_BYTES - LDSCTL_OFF) / 4; u += NWAVES * 64) ((LAS unsigned*)(F.lds + LDSCTL_OFF))[u] = 0u;
    __syncthreads();
    XcdBarrier bar; bar.bar = (unsigned*)(F.ctl + CW_BAR); bar.x = 0; bar.st = nullptr;
    if (N_LAUNCHES == 1) bar = xcd_barrier_post((unsigned*)(F.ctl + CW_BAR), F.MISC + 8);
#define GRID_BAR() do { if (N_LAUNCHES == 1) xcd_barrier(bar); } while (0)
    const int lo = args.ph_lo, hi = args.ph_hi;
#define IN(k) (lo <= (k) && (k) < hi)
#define BOTH(k) (IN(k) && IN((k) + 1))
    if (((PHASE_MASK >> 0) & 1) && IN(0)) { p0_prologue(F); if (BOTH(0)) GRID_BAR(); }
    if (((PHASE_MASK >> 1) & 1) && IN(1)) { phase_inproj_a(F); if (BOTH(1)) GRID_BAR(); }
    if (((PHASE_MASK >> 2) & 1) && IN(2)) { phase_attn_naive(F); if (BOTH(2)) GRID_BAR(); }
    if (((PHASE_MASK >> 3) & 1) && IN(3)) { phase_outproj_a(F); if (BOTH(3)) GRID_BAR(); }
    if (((PHASE_MASK >> 4) & 1) && IN(4)) { phase_inproj_b(F); if (BOTH(4)) GRID_BAR(); }
    if (((PHASE_MASK >> 5) & 1) && IN(5)) { phase_chunk_naive(F); if (BOTH(5)) GRID_BAR(); }
    if (((PHASE_MASK >> 6) & 1) && IN(6)) { phase_scan(F); if (BOTH(6)) GRID_BAR(); }
    if (((PHASE_MASK >> 7) & 1) && IN(7)) { phase_mlstm_out_naive(F); if (BOTH(7)) GRID_BAR(); }
    if (((PHASE_MASK >> 8) & 1) && IN(8)) { phase_outproj_b(F); if (BOTH(8)) GRID_BAR(); }
    if (((PHASE_MASK >> 9) & 1) && IN(9)) { phase_final_norm(F); }
#undef IN
#undef BOTH
}

extern "C" void kernel_launch(void* const* d_in, const int* in_sizes, int n_in, void* d_out, int out_size, void* d_ws, size_t ws_size, hipStream_t stream) {
    static int grid = 0;
    if (grid == 0) {
        if (n_in != 11 || in_sizes[0] != NTOK * DM || out_size != NTOK * DM || ws_size < WS_END) { fprintf(stderr, "kernel_launch: unexpected shapes (n_in %d, in0 %d, out %d, ws %zu); nothing launched\n", n_in, n_in > 0 ? in_sizes[0] : -1, out_size, ws_size); grid = -1; return; }
        int dev = 0, cus = 0, per_cu = 0;
        if (hipGetDevice(&dev) != hipSuccess || hipDeviceGetAttribute(&cus, hipDeviceAttributeMultiprocessorCount, dev) != hipSuccess) { fprintf(stderr, "kernel_launch: device query failed\n"); grid = -1; return; }
        if (hipFuncSetAttribute((const void*)fwd_kernel, hipFuncAttributeMaxDynamicSharedMemorySize, LDS_BYTES) != hipSuccess) { fprintf(stderr, "kernel_launch: hipFuncSetAttribute failed\n"); grid = -1; return; }
        if (hipOccupancyMaxActiveBlocksPerMultiprocessor(&per_cu, (const void*)fwd_kernel, NWAVES * 64, LDS_BYTES) != hipSuccess || per_cu < 1) { fprintf(stderr, "kernel_launch: occupancy query reports %d workgroups per CU\n", per_cu); per_cu = 1; }
        (void)hipGetLastError();
        grid = cus;
        if (grid != 256) fprintf(stderr, "kernel_launch: %d CUs (expected 256)\n", grid);
    }
    if (grid < 0) return;
    (void)hipMemsetAsync((char*)d_ws + WS_CTL, 0, CTL_ZERO_BYTES, stream);
    Args a{};
    for (int i = 0; i < 11; ++i) a.in[i] = (const float*)d_in[i];
    a.out = (float*)d_out; a.ws = (unsigned char*)d_ws;
    if (N_LAUNCHES == 1) { a.ph_lo = 0; a.ph_hi = NPHASE; hipLaunchKernelGGL(fwd_kernel, dim3(grid), dim3(NWAVES * 64), LDS_BYTES, stream, a); }
    else for (int p = 0; p < NPHASE; ++p) { a.ph_lo = p; a.ph_hi = p + 1; hipLaunchKernelGGL(fwd_kernel, dim3(grid), dim3(NWAVES * 64), LDS_BYTES, stream, a); }
}
```

```cpp
#include <hip/hip_runtime.h>
#include <cstdio>
#include <cstdint>
namespace pg8 {
#define PG8_LAS __attribute__((address_space(3)))
typedef unsigned short bf16_t;
typedef short bf16x8 __attribute__((ext_vector_type(8)));
typedef float f32x4 __attribute__((ext_vector_type(4)));
typedef unsigned u32x4 __attribute__((ext_vector_type(4)));
constexpr int BM = 256, BK = 64, HALF = 128, HTB = HALF * BK * 2  , STAGE_BYTES = 8 * HTB, NXCD = 8, WGM = 8;

__host__ __device__ __forceinline__ int lds_byte(int r, int c) { const int st = (r >> 4) * 2 + (c >> 5), rr = r & 15, cc = c & 31, ob = rr * 64 + cc * 2; return st * 1024 + (ob ^ (((ob >> 9) & 1) << 5)); }
__host__ __device__ __forceinline__ void stage_rc(int b, int& R, int& C) { const int st = b / 1024, sb = b % 1024, swz = sb ^ (((sb >> 9) & 1) << 5); R = (st >> 1) * 16 + swz / 64; C = (st & 1) * 32 + (swz % 64) / 2; }
__host__ __device__ __forceinline__ int perm32(int rho) { const int n = rho >> 4, i = rho & 15; return 8 * (i >> 2) + 4 * n + (i & 3); }

struct Unit { int pm, pn; };
struct Gemm { const bf16_t* A; const bf16_t* Bt; int M, N, K; };

struct StaticOrder {
    int nM, nN, nwg, G, c;
    __host__ __device__ void init(int M, int N, int G_, int c_) { nM = M / BM; nN = N / BM; nwg = nM * nN; G = G_; c = c_; }
    __host__ __device__ bool next(int i, Unit& u) const {
        const long L = (long)i * G + c; if (L >= nwg) return false;
        int wgid = (int)L; { const int q = nwg / NXCD, r = nwg % NXCD, xcd = wgid % NXCD, off = wgid / NXCD; wgid = (xcd < r ? xcd * (q + 1) : r * (q + 1) + (xcd - r) * q) + off; }
        const int nig = WGM * nN, gid = wgid / nig, fm = gid * WGM, gsz = (nM - fm) < WGM ? (nM - fm) : WGM;
        u.pm = fm + ((wgid % nig) % gsz); u.pn = (wgid % nig) / gsz; return true;
    }
    __device__ __forceinline__ void a_ready(const Unit&) const {}
    __device__ __forceinline__ void done(const Unit&) const {}
};

__device__ __forceinline__ unsigned cvt_pk_bf16(float lo, float hi) { unsigned r; asm volatile("v_cvt_pk_bf16_f32 %0, %1, %2" : "=v"(r) : "v"(lo), "v"(hi)); return r; }
template <class Epi, class Sched, bool ALIGN_EPI = false, bool SP2 = false>
__device__ __forceinline__ void gemm_phase(PG8_LAS unsigned char* lds, const Gemm g, const Sched& S, const Epi& E) {
    const int tid = threadIdx.x, wid = __builtin_amdgcn_readfirstlane(tid >> 6), lane = tid & 63, wr = wid >> 2, wc = wid & 3, fr = lane & 15, fq = lane >> 4;
    const int K = g.K, nt = K / BK;
    unsigned voffA[2], voffB[2];
#pragma unroll
    for (int i = 0; i < 2; ++i) { int R, C; stage_rc(tid * 16 + i * 8192, R, C); const int Rb = Epi::PERM ? ((R & ~31) + perm32(R & 31)) : R;
        voffA[i] = (unsigned)(R * K + C) * 2u; voffB[i] = (unsigned)(Rb * K + C) * 2u; }
    const size_t kstep = (size_t)(BK * 2);
    const size_t hstep = (size_t)HALF * K * 2;
    const size_t tstep = 2 * hstep;
    const unsigned ldsw = (unsigned)wid * 1024u;
    const int aoff = lds_byte(wr * 64 + fr, fq * 8), boff = lds_byte(wc * 32 + fr, fq * 8);
#define PG8_SA(b, h) (((b) * 2 + (h)) * HTB)
#define PG8_SB(b, h) ((4 + (b) * 2 + (h)) * HTB)
#define PG8_STAGE(bufoff, gbase, voff) do { _Pragma("unroll") for (int _i = 0; _i < 2; ++_i) \
        __builtin_amdgcn_global_load_lds((const unsigned*)((const char*)(gbase) + (voff)[_i]), (PG8_LAS unsigned*)(lds + (bufoff) + ldsw + _i * 8192), 16, 0, 0); } while (0)
#define PG8_LDA(dst, b, h) do { _Pragma("unroll") for (int m = 0; m < 4; ++m) _Pragma("unroll") for (int k = 0; k < 2; ++k) dst[m][k] = *(const PG8_LAS bf16x8*)(lds + PG8_SA(b, h) + aoff + m * 2048 + k * 1024); } while (0)
#define PG8_LDB(dst, b, h) do { _Pragma("unroll") for (int n = 0; n < 2; ++n) _Pragma("unroll") for (int k = 0; k < 2; ++k) dst[n][k] = *(const PG8_LAS bf16x8*)(lds + PG8_SB(b, h) + boff + n * 2048 + k * 1024); } while (0)
#define PG8_MMA(ai, bj, At, Bt) do { __builtin_amdgcn_s_setprio(1); _Pragma("unroll") for (int m = 0; m < 4; ++m) _Pragma("unroll") for (int n = 0; n < 2; ++n) _Pragma("unroll") for (int k = 0; k < 2; ++k) \
        acc[ai][bj][m][n] = __builtin_amdgcn_mfma_f32_16x16x32_bf16(Bt[n][k], At[m][k], acc[ai][bj][m][n], 0, 0, 0); __builtin_amdgcn_s_setprio(0); } while (0)
#define PG8_WAIT_V(n) asm volatile("s_waitcnt vmcnt(" #n ")" ::: "memory")
#define PG8_WAIT_L(n) asm volatile("s_waitcnt lgkmcnt(" #n ")" ::: "memory")
#define PG8_BAR __builtin_amdgcn_s_barrier()
#define PG8_SCHED __builtin_amdgcn_sched_barrier(0)
    Unit cur, nxt; int ui = 0;
    if (!S.next(0, cur)) return;
    f32x4 acc[2][2][4][2];
#pragma unroll
    for (int a = 0; a < 2; ++a)
#pragma unroll
        for (int b = 0; b < 2; ++b)
#pragma unroll
            for (int m = 0; m < 4; ++m)
#pragma unroll
                for (int n = 0; n < 2; ++n) acc[a][b][m][n] = (f32x4){0.f, 0.f, 0.f, 0.f};
    bf16x8 At[4][2], B0[2][2], B1[2][2];
    const char* cA = (const char*)g.A + (size_t)cur.pm * tstep; const char* cB = (const char*)g.Bt + (size_t)cur.pn * tstep;
    S.a_ready(cur);
    if constexpr (SP2) {
        PG8_STAGE(PG8_SB(0, 0), cB, voffB); PG8_STAGE(PG8_SB(0, 1), cB + hstep, voffB); PG8_STAGE(PG8_SA(0, 0), cA, voffA); PG8_STAGE(PG8_SA(0, 1), cA + hstep, voffA);
        if (wr == 1) PG8_BAR;
        PG8_WAIT_V(2); PG8_BAR;
        PG8_STAGE(PG8_SB(1, 0), cB + kstep, voffB); PG8_STAGE(PG8_SA(1, 0), cA + kstep, voffA); PG8_STAGE(PG8_SB(1, 1), cB + hstep + kstep, voffB);
        PG8_WAIT_V(6); PG8_BAR;
    } else {
        PG8_STAGE(PG8_SB(0, 0), cB, voffB); PG8_STAGE(PG8_SA(0, 0), cA, voffA); PG8_STAGE(PG8_SB(0, 1), cB + hstep, voffB); PG8_STAGE(PG8_SA(0, 1), cA + hstep, voffA);
        if (wr == 1) PG8_BAR;
        PG8_WAIT_V(4); PG8_BAR;
        PG8_STAGE(PG8_SB(1, 0), cB + kstep, voffB); PG8_STAGE(PG8_SA(1, 0), cA + kstep, voffA); PG8_STAGE(PG8_SB(1, 1), cB + hstep + kstep, voffB);
        PG8_WAIT_V(6); PG8_BAR;
    }
    for (;;) {
        const bool has_next = S.next(ui + 1, nxt);
        const char* nA = has_next ? (const char*)g.A + (size_t)nxt.pm * tstep : cA; const char* nB = has_next ? (const char*)g.Bt + (size_t)nxt.pn * tstep : cB;
        for (int t = 0; t < nt; t += 2) {
            const bool last = (t == nt - 2);
            const char* a1 = cA + (size_t)(t + 1) * kstep;
            const char* a2 = last ? nA : cA + (size_t)(t + 2) * kstep; const char* b2 = last ? nB : cB + (size_t)(t + 2) * kstep;
            const char* a3 = a2 + kstep; const char* b3 = b2 + kstep;
            if (last && has_next) S.a_ready(nxt);
            if constexpr (SP2) {
            PG8_LDB(B0, 0, 0); PG8_LDB(B1, 0, 1); PG8_SCHED; PG8_LDA(At, 0, 0); PG8_STAGE(PG8_SA(1, 1), a1 + hstep, voffA);
            PG8_WAIT_V(8); PG8_WAIT_L(0); PG8_BAR; PG8_MMA(0, 0, At, B0); PG8_MMA(0, 1, At, B1); PG8_BAR; PG8_SCHED;
            PG8_LDA(At, 0, 1); PG8_STAGE(PG8_SB(0, 0), b2, voffB); PG8_STAGE(PG8_SB(0, 1), b2 + hstep, voffB); PG8_STAGE(PG8_SA(0, 0), a2, voffA);
            PG8_WAIT_V(8); PG8_WAIT_L(0); PG8_BAR; PG8_MMA(1, 0, At, B0); PG8_MMA(1, 1, At, B1); PG8_BAR; PG8_SCHED;
            PG8_LDB(B0, 1, 0); PG8_LDB(B1, 1, 1); PG8_SCHED; PG8_LDA(At, 1, 0); PG8_STAGE(PG8_SA(0, 1), a2 + hstep, voffA);
            PG8_WAIT_V(8); PG8_WAIT_L(0); PG8_BAR; PG8_MMA(0, 0, At, B0); PG8_MMA(0, 1, At, B1); PG8_BAR; PG8_SCHED;
            PG8_LDA(At, 1, 1); PG8_STAGE(PG8_SB(1, 0), b3, voffB); PG8_STAGE(PG8_SB(1, 1), b3 + hstep, voffB); PG8_STAGE(PG8_SA(1, 0), a3, voffA);
            PG8_WAIT_V(8); PG8_WAIT_L(0); PG8_BAR; PG8_MMA(1, 0, At, B0); PG8_MMA(1, 1, At, B1); PG8_BAR; PG8_SCHED;
            } else {
            PG8_LDB(B0, 0, 0); PG8_SCHED; PG8_LDA(At, 0, 0); PG8_STAGE(PG8_SA(1, 1), a1 + hstep, voffA);
            PG8_WAIT_L(8); PG8_BAR; PG8_WAIT_L(0); PG8_MMA(0, 0, At, B0); PG8_BAR; PG8_SCHED;
            PG8_LDB(B1, 0, 1); PG8_STAGE(PG8_SB(0, 0), b2, voffB);
            PG8_BAR; PG8_WAIT_L(0); PG8_MMA(0, 1, At, B1); PG8_BAR;
            PG8_LDA(At, 0, 1); PG8_STAGE(PG8_SA(0, 0), a2, voffA);
            PG8_BAR; PG8_WAIT_L(0); PG8_MMA(1, 0, At, B0); PG8_BAR; PG8_SCHED;
            PG8_STAGE(PG8_SB(0, 1), b2 + hstep, voffB);
            PG8_WAIT_V(6); PG8_BAR; PG8_MMA(1, 1, At, B1); PG8_BAR;
            PG8_LDB(B0, 1, 0); PG8_SCHED; PG8_LDA(At, 1, 0); PG8_STAGE(PG8_SA(0, 1), a2 + hstep, voffA);
            PG8_WAIT_L(8); PG8_BAR; PG8_WAIT_L(0); PG8_MMA(0, 0, At, B0); PG8_BAR; PG8_SCHED;
            PG8_LDB(B1, 1, 1); PG8_STAGE(PG8_SB(1, 0), b3, voffB);
            PG8_BAR; PG8_WAIT_L(0); PG8_MMA(0, 1, At, B1); PG8_BAR;
            PG8_LDA(At, 1, 1); PG8_STAGE(PG8_SA(1, 0), a3, voffA);
            PG8_BAR; PG8_WAIT_L(0); PG8_MMA(1, 0, At, B0); PG8_BAR; PG8_SCHED;
            PG8_STAGE(PG8_SB(1, 1), b3 + hstep, voffB);
            PG8_WAIT_V(6); PG8_BAR; PG8_MMA(1, 1, At, B1); PG8_BAR;
            }
        }
        if constexpr (ALIGN_EPI) { if (wr == 0) PG8_BAR; }
        if constexpr (!Epi::AFTER_DRAIN) { E(acc, cur, wr, wc, fr, fq); S.done(cur); }
        if (!has_next) break;
#pragma unroll
        for (int a = 0; a < 2; ++a)
#pragma unroll
            for (int b = 0; b < 2; ++b)
#pragma unroll
                for (int m = 0; m < 4; ++m)
#pragma unroll
                    for (int n = 0; n < 2; ++n) acc[a][b][m][n] = (f32x4){0.f, 0.f, 0.f, 0.f};
        cur = nxt; cA = nA; cB = nB; ++ui;
        if constexpr (ALIGN_EPI) { if (wr == 1) PG8_BAR; }
    }
    PG8_WAIT_V(0);
    if constexpr (!ALIGN_EPI) { if (wr == 0) PG8_BAR; }
    PG8_BAR;
    if constexpr (Epi::AFTER_DRAIN) { E.fused(acc, cur, wr, wc, fr, fq, lds, wid, lane); S.done(cur); }
#undef PG8_SA
#undef PG8_SB
#undef PG8_STAGE
#undef PG8_LDA
#undef PG8_LDB
#undef PG8_MMA
#undef PG8_WAIT_V
#undef PG8_WAIT_L
#undef PG8_BAR
#undef PG8_SCHED
}
}

#define DI __device__ __forceinline__
#define GAS __attribute__((address_space(1)))
#define LAS __attribute__((address_space(3)))
typedef unsigned short bf16;
typedef unsigned v4u __attribute__((ext_vector_type(4)));
typedef unsigned v2u __attribute__((ext_vector_type(2)));
typedef float f32x4 __attribute__((ext_vector_type(4)));
typedef short bf16x8 __attribute__((ext_vector_type(8)));
typedef GAS unsigned gu32;
typedef GAS unsigned long long gu64;
#define RLX_AGENT __ATOMIC_RELAXED, __HIP_MEMORY_SCOPE_AGENT
#define LDS_WAIT() asm volatile("s_waitcnt lgkmcnt(0)" ::: "memory")
#define VM_WAIT() asm volatile("s_waitcnt vmcnt(0)" ::: "memory")

constexpr int NWAVES = 8;
constexpr int DM = 1024, SEQ = 8192, NTOK = 2 * SEQ, RB0 = 128, NROW = NTOK + RB0;
constexpr int A_IN = 2304, B_MAIN = 4096, B_IN = 4112, NCHUNK = 65, NUNIT = 16 * NCHUNK;
constexpr float RMS_EPS = 1e-6f;
#ifndef MK_N_LAUNCHES
#define MK_N_LAUNCHES 1
#endif
constexpr int NPHASE = 10;
constexpr int N_LAUNCHES = MK_N_LAUNCHES;

constexpr size_t MiB = 1u << 20;
constexpr size_t WS_CTL = 0, CTL_ZERO_BYTES = 64 * 1024;
constexpr size_t WS_WA = 1 * MiB, WS_WOA = 6 * MiB, WS_WB = 8 * MiB, WS_WOB = 17 * MiB;
constexpr size_t WS_RSTD0 = 19 * MiB, WS_SSQ1 = 20 * MiB, WS_GATES = 22 * MiB, WS_SSQ2 = 24 * MiB, WS_STAT = 25 * MiB;
constexpr size_t ST_NCHK = 0, ST_MLOC = 512 * 1024, ST_GTOT = 520 * 1024, ST_MPREV = 528 * 1024, ST_NPREV = 544 * 1024;
constexpr size_t WS_RA = 26 * MiB;
constexpr size_t WS_RB = 59 * MiB;
constexpr size_t WS_RC = 92 * MiB;
constexpr size_t WS_K = 125 * MiB, WS_V = 130 * MiB;
constexpr size_t WS_PB = 92 * MiB;
constexpr size_t WS_G = 157 * MiB;
constexpr size_t WS_END = 190 * MiB;
constexpr size_t OUT_CCH = 0, OUT_CPREV = 33 * MiB;
static_assert(WS_WA + (size_t)A_IN * DM * 2 <= WS_WOA && WS_WB + (size_t)B_IN * DM * 2 <= WS_WOB && WS_RA + (size_t)NROW * DM * 2 <= WS_RB && WS_RB + (size_t)NROW * DM * 2 <= WS_RC, "ws map");
static_assert(WS_RC + (size_t)NROW * DM * 2 <= WS_K && WS_K + (size_t)NROW * 256 <= WS_V && WS_V + (size_t)NROW * 256 <= WS_G && WS_PB + (size_t)NROW * 4096 <= WS_G && WS_G + (size_t)NROW * 2048 <= WS_END, "ws map");
static_assert((size_t)NUNIT * 8192 * 4 <= OUT_CPREV && OUT_CPREV + (size_t)NUNIT * 8192 * 2 <= (size_t)NTOK * DM * 4, "d_out scratch map");
constexpr int CW_BAR = 4096;
constexpr int LDS_BYTES = 163840;
constexpr int RING_BYTES = 131072, LDSCTL_OFF = 160 * 1024 - 512, MISC_OFF = LDSCTL_OFF + 320;

DI float bf2f(bf16 b) { return __uint_as_float((unsigned)b << 16); }
DI unsigned f2bf(float f) { unsigned u = __float_as_uint(f); return (u + 0x7fffu + ((u >> 16) & 1u)) >> 16; }
DI unsigned pk2(float lo, float hi) { return f2bf(lo) | (f2bf(hi) << 16); }
DI float blo(unsigned w) { return __uint_as_float(w << 16); }
DI float bhi(unsigned w) { return __uint_as_float(w & 0xffff0000u); }
DI float wave_sum(float v) {
#pragma unroll
    for (int o = 1; o < 64; o <<= 1) v += __shfl_xor(v, o);
    return v;
}
DI float wave_max(float v) {
#pragma unroll
    for (int o = 1; o < 64; o <<= 1) v = fmaxf(v, __shfl_xor(v, o));
    return v;
}
DI float sigmoidf_(float x) { return 1.0f / (1.0f + __expf(-x)); }
DI float siluf_(float x) { return x / (1.0f + __expf(-x)); }
DI float logsigmoidf_(float x) { return fminf(x, 0.f) - __logf(1.0f + __expf(-fabsf(x))); }
DI float dot8(v4u a, v4u b) {
    return blo(a.x) * blo(b.x) + bhi(a.x) * bhi(b.x) + blo(a.y) * blo(b.y) + bhi(a.y) * bhi(b.y) + blo(a.z) * blo(b.z) + bhi(a.z) * bhi(b.z) + blo(a.w) * blo(b.w) + bhi(a.w) * bhi(b.w);
}

DI int chunk_row0(int b, int n) { return n == 0 ? 0 : RB0 + b * SEQ + (n - 1) * 128; }
constexpr float ROPE_C = 0.41524101186092029f;
DI void rope_pair(float& x1, float& x2, float pos, float inv) {
    const float ang = pos * inv;
    float rev = ang * 0.15915494309189535f; rev = rev - floorf(rev);
    const float s = __builtin_amdgcn_sinf(rev), c = __builtin_amdgcn_cosf(rev);
    const float o1 = x1 * c - x2 * s, o2 = x2 * c + x1 * s; x1 = o1; x2 = o2;
}
struct ADst { bf16* Q; bf16* K; bf16* V; bf16* SZ; };
DI void epiA_quad(f32x4 v, int r, int gcol, float pos, const ADst& d) {
    float a = v[0], b = v[1], c = v[2], e = v[3]; bf16* dst;
    if (gcol < 1152) {
        const int i0 = (gcol & 63) >> 1;
        rope_pair(a, b, pos, __builtin_amdgcn_exp2f(-(float)i0 * ROPE_C)); rope_pair(c, e, pos, __builtin_amdgcn_exp2f(-(float)(i0 + 1) * ROPE_C));
        dst = gcol < 1024 ? d.Q + (size_t)r * DM + gcol : d.K + (size_t)r * 128 + (gcol - 1024);
    } else if (gcol < 1280) dst = d.V + (size_t)r * 128 + (gcol - 1152);
    else { a = siluf_(a); b = siluf_(b); c = siluf_(c); e = siluf_(e); dst = d.SZ + (size_t)r * DM + (gcol - 1280); }
    v2u w; w.x = pg8::cvt_pk_bf16(a, b); w.y = pg8::cvt_pk_bf16(c, e); *(v2u*)dst = w;
}
struct EpiA {
    static constexpr bool PERM = true, AFTER_DRAIN = false;
    ADst d; const float* rstd0;
    DI void operator()(const pg8::f32x4 (&acc)[2][2][4][2], const pg8::Unit& u, int wr, int wc, int fr, int fq) const {
        float rs[2][4];
#pragma unroll
        for (int ai = 0; ai < 2; ++ai)
#pragma unroll
            for (int m = 0; m < 4; ++m) rs[ai][m] = rstd0[RB0 + u.pm * 256 + ai * 128 + wr * 64 + m * 16 + fr];
#pragma unroll
        for (int bj = 0; bj < 2; ++bj) {
            const int gc = u.pn * 256 + bj * 128, gcol = gc + wc * 32 + 8 * fq;
            if (gc < 1152) {
                const int i0 = (gcol & 63) >> 1; float inv[4];
#pragma unroll
                for (int p = 0; p < 4; ++p) inv[p] = __builtin_amdgcn_exp2f(-(float)(i0 + p) * ROPE_C);
                bf16* base = gc < 1024 ? d.Q + gcol : d.K + (gcol - 1024); const int ld = gc < 1024 ? DM : 128;
#pragma unroll
                for (int ai = 0; ai < 2; ++ai)
#pragma unroll
                    for (int m = 0; m < 4; ++m) {
                        const int rt = u.pm * 256 + ai * 128 + wr * 64 + m * 16 + fr; const float pos = (float)(16 + (rt & (SEQ - 1)));
                        f32x4 v0 = acc[ai][bj][m][0] * rs[ai][m], v1 = acc[ai][bj][m][1] * rs[ai][m];
                        float a0 = v0[0], a1 = v0[1], a2 = v0[2], a3 = v0[3], b0 = v1[0], b1 = v1[1], b2 = v1[2], b3 = v1[3];
                        rope_pair(a0, a1, pos, inv[0]); rope_pair(a2, a3, pos, inv[1]); rope_pair(b0, b1, pos, inv[2]); rope_pair(b2, b3, pos, inv[3]);
                        v4u w; w.x = pg8::cvt_pk_bf16(a0, a1); w.y = pg8::cvt_pk_bf16(a2, a3); w.z = pg8::cvt_pk_bf16(b0, b1); w.w = pg8::cvt_pk_bf16(b2, b3);
                        *(v4u*)(base + (size_t)(RB0 + rt) * ld) = w;
                    }
            } else {
                const bool isz = gc >= 1280;
                bf16* base = isz ? d.SZ + (gcol - 1280) : d.V + (gcol - 1152); const int ld = isz ? DM : 128;
#pragma unroll
                for (int ai = 0; ai < 2; ++ai)
#pragma unroll
                    for (int m = 0; m < 4; ++m) {
                        const int rt = u.pm * 256 + ai * 128 + wr * 64 + m * 16 + fr;
                        f32x4 v0 = acc[ai][bj][m][0] * rs[ai][m], v1 = acc[ai][bj][m][1] * rs[ai][m];
                        if (isz) {
#pragma unroll
                            for (int j = 0; j < 4; ++j) { v0[j] = siluf_(v0[j]); v1[j] = siluf_(v1[j]); } }
                        v4u w; w.x = pg8::cvt_pk_bf16(v0[0], v0[1]); w.y = pg8::cvt_pk_bf16(v0[2], v0[3]); w.z = pg8::cvt_pk_bf16(v1[0], v1[1]); w.w = pg8::cvt_pk_bf16(v1[2], v1[3]);
                        *(v4u*)(base + (size_t)(RB0 + rt) * ld) = w;
                    }
            }
        }
    }
};
DI void row_partials_reduce(const float (&ss)[2][4], float* dst  , LAS float* xl, int wr, int wc, int fr, int fq) {
#pragma unroll
    for (int ai = 0; ai < 2; ++ai)
#pragma unroll
        for (int m = 0; m < 4; ++m) if (fq == 0) xl[(ai * 128 + wr * 64 + m * 16 + fr) * 4 + wc] = ss[ai][m];
    asm volatile("s_waitcnt lgkmcnt(0)" ::: "memory"); __builtin_amdgcn_s_barrier(); asm volatile("" ::: "memory");
    const int t = threadIdx.x;
    if (t < 256) { const f32x4 p = *(const LAS f32x4*)(xl + t * 4); dst[t] = (p[0] + p[1]) + (p[2] + p[3]); }
}
struct EpiOutA {
    static constexpr bool PERM = true, AFTER_DRAIN = false;
    const float* x; bf16* H1; float* ssq; LAS float* xl;
    DI void operator()(const pg8::f32x4 (&acc)[2][2][4][2], const pg8::Unit& u, int wr, int wc, int fr, int fq) const {
        float ssv[2][4];
#pragma unroll
        for (int ai = 0; ai < 2; ++ai)
#pragma unroll
            for (int m = 0; m < 4; ++m) {
                const int rt = u.pm * 256 + ai * 128 + wr * 64 + m * 16 + fr; float ss = 0.f;
#pragma unroll
                for (int bj = 0; bj < 2; ++bj) {
                    const int col = u.pn * 256 + bj * 128 + wc * 32 + 8 * fq;
                    const f32x4 x0 = *(const f32x4*)(x + (size_t)rt * DM + col), x1 = *(const f32x4*)(x + (size_t)rt * DM + col + 4);
                    const f32x4 h0 = x0 + acc[ai][bj][m][0], h1 = x1 + acc[ai][bj][m][1];
                    ss += (h0[0] * h0[0] + h0[1] * h0[1]) + (h0[2] * h0[2] + h0[3] * h0[3]) + (h1[0] * h1[0] + h1[1] * h1[1]) + (h1[2] * h1[2] + h1[3] * h1[3]);
                    v4u w; w.x = pg8::cvt_pk_bf16(h0[0], h0[1]); w.y = pg8::cvt_pk_bf16(h0[2], h0[3]); w.z = pg8::cvt_pk_bf16(h1[0], h1[1]); w.w = pg8::cvt_pk_bf16(h1[2], h1[3]);
                    *(v4u*)(H1 + (size_t)(RB0 + rt) * DM + col) = w;
                }
                ss += __shfl_xor(ss, 16); ss += __shfl_xor(ss, 32); ssv[ai][m] = ss;
            }
        row_partials_reduce(ssv, ssq + (size_t)u.pn * NROW + RB0 + u.pm * 256, xl, wr, wc, fr, fq);
    }
};
DI float rstd_from4(const float* ssq, int stride, int r) {
    const float s = (ssq[r] + ssq[(size_t)stride + r]) + (ssq[(size_t)2 * stride + r] + ssq[(size_t)3 * stride + r]);
    return 1.0f / sqrtf(s * (1.0f / DM) + RMS_EPS);
}
DI float rstd_from16(const float* ssq, int stride, int r) {
    float s = 0.f;
#pragma unroll
    for (int p = 0; p < 16; ++p) s += ssq[(size_t)p * stride + r];
    return 1.0f / sqrtf(s * (1.0f / DM) + RMS_EPS);
}
DI float gate_oz(float o, float z) { return z / ((1.0f + __expf(-o)) * (1.0f + __expf(-z))); }
DI void epiB_quad(f32x4 v, int r, int gcol, bf16* PB, bf16* G) {
    if (gcol < 2048) { v2u w; w.x = pg8::cvt_pk_bf16(v[0], v[1]); w.y = pg8::cvt_pk_bf16(v[2], v[3]); *(v2u*)(PB + (size_t)r * 2048 + gcol) = w; }
    else { *(unsigned*)(G + (size_t)r * DM + ((gcol - 2048) >> 1)) = pg8::cvt_pk_bf16(gate_oz(v[0], v[1]), gate_oz(v[2], v[3])); }
}
struct EpiB {
    static constexpr bool PERM = true, AFTER_DRAIN = false;
    const float* ssq1; bf16* PB; bf16* G;
    DI void operator()(const pg8::f32x4 (&acc)[2][2][4][2], const pg8::Unit& u, int wr, int wc, int fr, int fq) const {
#pragma unroll
        for (int ai = 0; ai < 2; ++ai)
#pragma unroll
            for (int m = 0; m < 4; ++m) {
                const int r = RB0 + u.pm * 256 + ai * 128 + wr * 64 + m * 16 + fr;
                const float rs = rstd_from4(ssq1, NROW, r);
#pragma unroll
                for (int bj = 0; bj < 2; ++bj) {
                    const int gc = u.pn * 256 + bj * 128, gcol = gc + wc * 32 + 8 * fq;
                    const f32x4 v0 = acc[ai][bj][m][0] * rs, v1 = acc[ai][bj][m][1] * rs;
                    if (gc < 2048) {
                        v4u w; w.x = pg8::cvt_pk_bf16(v0[0], v0[1]); w.y = pg8::cvt_pk_bf16(v0[2], v0[3]); w.z = pg8::cvt_pk_bf16(v1[0], v1[1]); w.w = pg8::cvt_pk_bf16(v1[2], v1[3]);
                        *(v4u*)(PB + (size_t)r * 2048 + gcol) = w;
                    } else {
                        v2u w; w.x = pg8::cvt_pk_bf16(gate_oz(v0[0], v0[1]), gate_oz(v0[2], v0[3])); w.y = pg8::cvt_pk_bf16(gate_oz(v1[0], v1[1]), gate_oz(v1[2], v1[3]));
                        *(v2u*)(G + (size_t)r * DM + ((gcol - 2048) >> 1)) = w;
                    }
                }
            }
    }
};
struct EpiOutB {
    static constexpr bool PERM = true, AFTER_DRAIN = false;
    const bf16* H1; float* out; float* ssq; LAS float* xl;
    DI void operator()(const pg8::f32x4 (&acc)[2][2][4][2], const pg8::Unit& u, int wr, int wc, int fr, int fq) const {
        float ssv[2][4];
#pragma unroll
        for (int ai = 0; ai < 2; ++ai)
#pragma unroll
            for (int m = 0; m < 4; ++m) {
                const int rt = u.pm * 256 + ai * 128 + wr * 64 + m * 16 + fr; float ss = 0.f;
#pragma unroll
                for (int bj = 0; bj < 2; ++bj) {
                    const int col = u.pn * 256 + bj * 128 + wc * 32 + 8 * fq;
                    const v4u hw = *(const v4u*)(H1 + (size_t)(RB0 + rt) * DM + col);
                    f32x4 h0 = acc[ai][bj][m][0], h1 = acc[ai][bj][m][1];
                    h0[0] += blo(hw.x); h0[1] += bhi(hw.x); h0[2] += blo(hw.y); h0[3] += bhi(hw.y); h1[0] += blo(hw.z); h1[1] += bhi(hw.z); h1[2] += blo(hw.w); h1[3] += bhi(hw.w);
                    ss += (h0[0] * h0[0] + h0[1] * h0[1]) + (h0[2] * h0[2] + h0[3] * h0[3]) + (h1[0] * h1[0] + h1[1] * h1[1]) + (h1[2] * h1[2] + h1[3] * h1[3]);
                    *(f32x4*)(out + (size_t)rt * DM + col) = h0; *(f32x4*)(out + (size_t)rt * DM + col + 4) = h1;
                }
                ss += __shfl_xor(ss, 16); ss += __shfl_xor(ss, 32); ssv[ai][m] = ss;
            }
        row_partials_reduce(ssv, ssq + (size_t)u.pn * NTOK + u.pm * 256, xl, wr, wc, fr, fq);
    }
};

DI f32x4 thin_tile(const bf16* A, const bf16* Wt, int lane) {
    const bf16* ap = A + (size_t)(lane & 15) * DM + 8 * (lane >> 4);
    const bf16* bp = Wt + (size_t)(lane & 15) * DM + 8 * (lane >> 4);
    f32x4 acc = (f32x4){0.f, 0.f, 0.f, 0.f};
#pragma unroll 8
    for (int k0 = 0; k0 < DM; k0 += 32) {
        const bf16x8 a = *(const bf16x8*)(ap + k0), b = *(const bf16x8*)(bp + k0);
        acc = __builtin_amdgcn_mfma_f32_16x16x32_bf16(b, a, acc, 0, 0, 0);
    }
    return acc;
}

struct Frame {
    LAS unsigned char* lds;
    volatile LAS unsigned* MISC;
    gu32* ctl;
    int tid, lane, wave, G;
    const float *x, *meta, *norm_a, *w_in_a, *sinks, *w_out_a, *norm_b, *w_in_b, *b_gates, *w_out_b, *norm_f; float* out;
    bf16 *WA, *WOA, *WB, *WOB;
    float *RSTD0, *SSQ1, *SSQM, *GATES, *SSQ2, *NCHK, *MLOC, *GTOT, *MPREV, *NPREV, *CCH;
    bf16 *XB, *YA, *YB, *Q, *H1, *SZ, *K, *V, *PB, *GG, *CPREV;
};

struct ColMapA {
    DI int col(int n) const { if (n < 1152) { const int hd = n >> 6, j = n & 63; return hd * 64 + (j >> 1) + 32 * (j & 1); } return n; }
    DI float scale(int) const { return 1.f; }
};
struct ColMapB {
    DI int col(int n) const { if (n >= 2048 && n < 4096) { const int j = (n - 2048) >> 1, e = n & 1; return 2048 + j + 1024 * e; } return n; }
    DI float scale(int n) const { return (n >= 512 && n < 1024) ? 0.125f : 1.f; }
};
struct ColMapId { DI int col(int n) const { return n; } DI float scale(int) const { return 1.f; } };
template <class CM>
DI void p0_item(const float* W, int K, int Nsrc, int Ndst, bf16* WT, const float* gain, LAS float* scr, int item, int lane, CM cm) {
    const int nblk = (Ndst + 31) / 32, kb = item / nblk, nb = item % nblk, k0 = 64 * kb, n0 = 32 * nb;
    const int nn = n0 + (lane & 31); const bool okc = nn < Ndst; const int src = okc ? cm.col(nn) : 0; const float sc = cm.scale(nn);
#pragma unroll 8
    for (int i = 0; i < 32; ++i) { const int kk = 2 * i + (lane >> 5); float v = 0.f;
        if (okc) { v = W[(size_t)(k0 + kk) * Nsrc + src] * sc; if (gain) v *= gain[k0 + kk]; }
        scr[kk * 33 + (lane & 31)] = v; }
    LDS_WAIT(); asm volatile("" ::: "memory");
    const int c = lane & 7;
#pragma unroll
    for (int j = 0; j < 4; ++j) { const int n = (lane >> 3) + 8 * j; const LAS float* s = scr + (8 * c) * 33 + n;
        v4u o; o.x = pk2(s[0 * 33], s[1 * 33]); o.y = pk2(s[2 * 33], s[3 * 33]); o.z = pk2(s[4 * 33], s[5 * 33]); o.w = pk2(s[6 * 33], s[7 * 33]);
        if (n0 + n < Ndst) *(GAS v4u*)(WT + (size_t)(n0 + n) * K + k0 + 8 * c) = o; }
    LDS_WAIT(); asm volatile("" ::: "memory");
}
DI void p0_row(const float* src, bf16* dst, float* rstd_out, int lane) {
    const GAS f32x4* xr = (const GAS f32x4*)src + lane;
    f32x4 v[4]; float s = 0.f;
#pragma unroll
    for (int j = 0; j < 4; ++j) { v[j] = xr[64 * j]; s += (v[j].x * v[j].x + v[j].y * v[j].y) + (v[j].z * v[j].z + v[j].w * v[j].w); }
    s = wave_sum(s);
    GAS v2u* o8 = (GAS v2u*)dst + lane;
#pragma unroll
    for (int j = 0; j < 4; ++j) { v2u w; w.x = pk2(v[j].x, v[j].y); w.y = pk2(v[j].z, v[j].w); o8[64 * j] = w; }
    if (lane == 0) *rstd_out = 1.0f / sqrtf(s * (1.0f / DM) + RMS_EPS);
}
DI void p0_prologue(Frame& F) {
    LAS float* scr = (LAS float*)(F.lds + F.wave * 16384);
    const int gw = blockIdx.x * NWAVES + F.wave, NGW = F.G * NWAVES;
    constexpr int I_A = 16 * 72, I_OA = 16 * 32, I_B = 16 * 129, I_OB = 16 * 32;
    for (int it = gw; it < I_A + I_OA + I_B + I_OB; it += NGW) {
        int r = it;
        if (r < I_A) { p0_item(F.w_in_a, DM, A_IN, A_IN, F.WA, F.norm_a, scr, r, F.lane, ColMapA()); continue; } r -= I_A;
        if (r < I_OA) { p0_item(F.w_out_a, DM, DM, DM, F.WOA, (const float*)nullptr, scr, r, F.lane, ColMapId()); continue; } r -= I_OA;
        if (r < I_B) { p0_item(F.w_in_b, DM, B_IN, B_IN, F.WB, F.norm_b, scr, r, F.lane, ColMapB()); continue; } r -= I_B;
        p0_item(F.w_out_b, DM, DM, DM, F.WOB, (const float*)nullptr, scr, r, F.lane, ColMapId());
    }
    for (int m = gw; m < 16 + NTOK; m += NGW) {
        if (m < 16) p0_row(F.meta + (size_t)m * DM, F.XB + (size_t)(112 + m) * DM, F.RSTD0 + 112 + m, F.lane);
        else p0_row(F.x + (size_t)(m - 16) * DM, F.XB + (size_t)(RB0 + m - 16) * DM, F.RSTD0 + RB0 + m - 16, F.lane);
    }
    const int gt = blockIdx.x * (NWAVES * 64) + F.tid;
    if (gt < 112 * 128 * 2 / 16) { ((v4u*)F.K)[gt] = (v4u){0u, 0u, 0u, 0u}; ((v4u*)F.V)[gt] = (v4u){0u, 0u, 0u, 0u}; }
}

DI void phase_inproj_a(Frame& F) {
    const ADst d{F.Q, F.K, F.V, F.SZ};
    { const int gw = blockIdx.x * NWAVES + F.wave;
      if (gw < A_IN / 16) {
          const f32x4 acc = thin_tile(F.XB + (size_t)112 * DM, F.WA + (size_t)gw * 16 * DM, F.lane);
          const int row = 112 + (F.lane & 15);
          epiA_quad(acc * F.RSTD0[row], row, 16 * gw + 4 * (F.lane >> 4), (float)(F.lane & 15), d);
      } }
    pg8::Gemm g{F.XB + (size_t)RB0 * DM, F.WA, NTOK, A_IN, DM}; pg8::StaticOrder S; S.init(NTOK, A_IN, F.G, (int)blockIdx.x);
    EpiA E{d, F.RSTD0};
    pg8::gemm_phase<EpiA, pg8::StaticOrder, true, true>(F.lds, g, S, E);
}

DI void phase_attn_naive(Frame& F) {
    const int gw = blockIdx.x * NWAVES + F.wave, NGW = F.G * NWAVES, lane = F.lane;
    for (int task = gw; task < (16 + NTOK) * 16; task += NGW) {
        const int head = task & 15, qi = task >> 4, kvh = head >> 3;
        int r, b, p;
        if (qi < 16) { r = 112 + qi; b = 0; p = r; } else { const int tok = qi - 16; b = tok >> 13; p = RB0 + (tok & (SEQ - 1)); r = RB0 + tok; }
        const bf16* qp = F.Q + (size_t)r * DM + head * 64;
        float s[2];
#pragma unroll
        for (int jj = 0; jj < 2; ++jj) {
            const int pk = p - 127 + lane + 64 * jj; const bool valid = pk >= 112; const int kr = valid ? (pk < RB0 ? pk : b * SEQ + pk) : 112;
            const bf16* kp = F.K + (size_t)kr * 128 + kvh * 64; float a = 0.f;
#pragma unroll
            for (int c = 0; c < 8; ++c) a += dot8(*(const v4u*)(qp + 8 * c), *(const v4u*)(kp + 8 * c));
            s[jj] = valid ? a * 0.125f : -INFINITY;
        }
        const float sink = F.sinks[head];
        const float m = fmaxf(wave_max(fmaxf(s[0], s[1])), sink);
        const float p0 = __expf(s[0] - m), p1 = __expf(s[1] - m);
        const float l = wave_sum(p0 + p1) + __expf(sink - m);
        float o = 0.f;
        for (int j = 0; j < 64; ++j) { const int pk = p - 127 + j; const float pj = __shfl(p0, j);
            if (pk >= 112) { const int kr = pk < RB0 ? pk : b * SEQ + pk; o += pj * bf2f(F.V[(size_t)kr * 128 + kvh * 64 + lane]); } }
        for (int j = 0; j < 64; ++j) { const int pk = p - 63 + j; const float pj = __shfl(p1, j);
            if (pk >= 112) { const int kr = pk < RB0 ? pk : b * SEQ + pk; o += pj * bf2f(F.V[(size_t)kr * 128 + kvh * 64 + lane]); } }
        o /= l;
        const size_t oi = (size_t)r * DM + head * 64 + lane;
        F.YA[oi] = (bf16)f2bf(o * bf2f(F.SZ[oi]));
    }
}

typedef float f32x16 __attribute__((ext_vector_type(16)));
typedef short s16x4 __attribute__((ext_vector_type(4)));
DI int crow(int r, int hi) { return (r & 3) + 8 * (r >> 2) + 4 * hi; }
DI s16x4 lds_tr(const LAS unsigned char* p) { typedef short v4i16_t __attribute__((ext_vector_type(4))); return __builtin_bit_cast(s16x4, __builtin_amdgcn_ds_read_tr16_b64_v4i16((LAS v4i16_t*)p)); }
DI bf16x8 cat8(s16x4 a, s16x4 b) { return (bf16x8){a[0], a[1], a[2], a[3], b[0], b[1], b[2], b[3]}; }
DI bf16x8 pack8(float a0, float a1, float a2, float a3, float a4, float a5, float a6, float a7) {
    v4u w; w.x = pg8::cvt_pk_bf16(a0, a1); w.y = pg8::cvt_pk_bf16(a2, a3); w.z = pg8::cvt_pk_bf16(a4, a5); w.w = pg8::cvt_pk_bf16(a6, a7); return __builtin_bit_cast(bf16x8, w);
}
DI void phase_attn(Frame& F) {
    LAS unsigned char* KL = F.lds;
    LAS unsigned char* VL = F.lds + 32768;
    LAS unsigned char* OST = F.lds + 65536 + F.wave * 4096;
    const int tid = F.tid, lane = F.lane, r32 = lane & 31, hi = lane >> 5;
    const int vlane = ((lane & 15) >> 2) * 64 + ((lane >> 4) & 1) * 32 + (lane & 3) * 8 + hi * 256;
    constexpr float C2 = 0.125f * 1.4426950408889634f;
    for (int unit = blockIdx.x; unit < 258; unit += F.G) {
        int b, n, kvh;
        if (unit < 256) { kvh = unit & 1; n = 1 + ((unit >> 1) & 63); b = unit >> 7; } else { kvh = unit - 256; n = 0; b = 0; }
        const int row0 = chunk_row0(b, n), prow0 = n <= 1 ? 0 : row0 - 128;
        for (int c = tid; c < 2048; c += 512) {
            const int key = c >> 3, ch = c & 7; v4u kv = (v4u){0u, 0u, 0u, 0u}, vv = kv;
            if (key >= 128 || n >= 1) { const size_t go = (size_t)(key < 128 ? prow0 + key : row0 + key - 128) * 128 + kvh * 64 + ch * 8; kv = *(const v4u*)(F.K + go); vv = *(const v4u*)(F.V + go); }
            *(LAS v4u*)(KL + key * 128 + ((ch ^ ((key >> 1) & 7)) << 4)) = kv;
            *(LAS v4u*)(VL + (ch >> 2) * 16384 + key * 64 + (ch & 3) * 16) = vv;
        }
        __syncthreads();
        const int head = kvh * 8 + F.wave; const float sink8 = F.sinks[head] * 8.0f;
        const int kposbase = 128 * (n - 1);
#pragma unroll 1
        for (int i = (n == 0 ? 3 : 0); i < 4; ++i) {
            const bf16* qp = F.Q + (size_t)(row0 + 32 * i + r32) * DM + head * 64 + 8 * hi;
            bf16x8 qf[4];
#pragma unroll
            for (int ks = 0; ks < 4; ++ks) qf[ks] = *(const bf16x8*)(qp + 16 * ks);
            f32x16 st[5];
#pragma unroll
            for (int tt = 0; tt < 5; ++tt) {
                const int key = 32 * (i + tt) + r32; const LAS unsigned char* kp = KL + key * 128; const int sw = (key >> 1) & 7;
                f32x16 acc = {0.f, 0.f, 0.f, 0.f, 0.f, 0.f, 0.f, 0.f, 0.f, 0.f, 0.f, 0.f, 0.f, 0.f, 0.f, 0.f};
#pragma unroll
                for (int ks = 0; ks < 4; ++ks) { const bf16x8 kf = *(const LAS bf16x8*)(kp + (((2 * ks + hi) ^ sw) << 4)); acc = __builtin_amdgcn_mfma_f32_32x32x16_bf16(kf, qf[ks], acc, 0, 0, 0); }
                st[tt] = acc;
            }
            float mx = -INFINITY;
#pragma unroll
            for (int tt = 0; tt < 5; ++tt)
#pragma unroll
                for (int r = 0; r < 16; ++r) {
                    const int kr = crow(r, hi); bool ok = true;
                    if (tt == 0) ok = kr > r32;
                    if (tt == 4) ok = kr <= r32;
                    if (n <= 1) ok = ok && (kposbase + 32 * (i + tt) + kr >= 112);
                    if (tt == 0 || tt == 4 || n <= 1) st[tt][r] = ok ? st[tt][r] : -INFINITY;
                    mx = fmaxf(mx, st[tt][r]);
                }
            mx = fmaxf(mx, __shfl_xor(mx, 32));
            const float m = fmaxf(mx, sink8), mc = m * C2;
            float l = 0.f;
#pragma unroll
            for (int tt = 0; tt < 5; ++tt)
#pragma unroll
                for (int r = 0; r < 16; ++r) { const float p = __builtin_amdgcn_exp2f(st[tt][r] * C2 - mc); st[tt][r] = p; l += p; }
            l += __shfl_xor(l, 32); l += __builtin_amdgcn_exp2f(sink8 * C2 - mc);
            const float il = 1.0f / l;
            f32x16 o0 = {0.f, 0.f, 0.f, 0.f, 0.f, 0.f, 0.f, 0.f, 0.f, 0.f, 0.f, 0.f, 0.f, 0.f, 0.f, 0.f}, o1 = o0;
#pragma unroll
            for (int tt = 0; tt < 5; ++tt)
#pragma unroll
                for (int s = 0; s < 2; ++s) {
                    const bf16x8 pa = pack8(st[tt][8 * s] * il, st[tt][8 * s + 1] * il, st[tt][8 * s + 2] * il, st[tt][8 * s + 3] * il, st[tt][8 * s + 4] * il, st[tt][8 * s + 5] * il, st[tt][8 * s + 6] * il, st[tt][8 * s + 7] * il);
                    const LAS unsigned char* vp = VL + (32 * (i + tt) + 16 * s) * 64 + vlane;
                    const bf16x8 v0 = cat8(lds_tr(vp), lds_tr(vp + 512)), v1 = cat8(lds_tr(vp + 16384), lds_tr(vp + 16384 + 512));
                    o0 = __builtin_amdgcn_mfma_f32_32x32x16_bf16(pa, v0, o0, 0, 0, 0);
                    o1 = __builtin_amdgcn_mfma_f32_32x32x16_bf16(pa, v1, o1, 0, 0, 0);
                }
#pragma unroll
            for (int r = 0; r < 16; ++r) { LAS bf16* sp = (LAS bf16*)(OST + crow(r, hi) * 128) + r32; sp[0] = (bf16)f2bf(o0[r]); sp[32] = (bf16)f2bf(o1[r]); }
            LDS_WAIT(); asm volatile("" ::: "memory");
#pragma unroll
            for (int it = 0; it < 4; ++it) {
                const int row = it * 8 + (lane >> 3), ch = lane & 7; const v4u ov = *(const LAS v4u*)(OST + row * 128 + ch * 16);
                const size_t gi = (size_t)(row0 + 32 * i + row) * DM + head * 64 + ch * 8; const v4u zv = *(const v4u*)(F.SZ + gi);
                v4u w; w.x = pg8::cvt_pk_bf16(blo(ov.x) * blo(zv.x), bhi(ov.x) * bhi(zv.x)); w.y = pg8::cvt_pk_bf16(blo(ov.y) * blo(zv.y), bhi(ov.y) * bhi(zv.y));
                w.z = pg8::cvt_pk_bf16(blo(ov.z) * blo(zv.z), bhi(ov.z) * bhi(zv.z)); w.w = pg8::cvt_pk_bf16(blo(ov.w) * blo(zv.w), bhi(ov.w) * bhi(zv.w));
                *(v4u*)(F.YA + gi) = w;
            }
            LDS_WAIT(); asm volatile("" ::: "memory");
        }
        __syncthreads();
    }
}

DI void phase_outproj_a(Frame& F) {
    { const int gw = blockIdx.x * NWAVES + F.wave;
      if (gw < 16) {
          const int row = 112 + (F.lane & 15); float ss = 0.f;
#pragma unroll
          for (int tt = 0; tt < 4; ++tt) {
              const f32x4 acc = thin_tile(F.YA + (size_t)112 * DM, F.WOA + (size_t)(gw * 64 + tt * 16) * DM, F.lane);
              const int col = gw * 64 + tt * 16 + 4 * (F.lane >> 4);
              const f32x4 h = *(const f32x4*)(F.meta + (size_t)(row - 112) * DM + col) + acc;
              ss += (h[0] * h[0] + h[1] * h[1]) + (h[2] * h[2] + h[3] * h[3]);
              v2u w; w.x = pg8::cvt_pk_bf16(h[0], h[1]); w.y = pg8::cvt_pk_bf16(h[2], h[3]); *(v2u*)(F.H1 + (size_t)row * DM + col) = w;
          }
          ss += __shfl_xor(ss, 16); ss += __shfl_xor(ss, 32);
          if (F.lane < 16) F.SSQM[gw * 16 + F.lane] = ss;
      } }
    pg8::Gemm g{F.YA + (size_t)RB0 * DM, F.WOA, NTOK, DM, DM}; pg8::StaticOrder S; S.init(NTOK, DM, F.G, (int)blockIdx.x);
    EpiOutA E{F.x, F.H1, F.SSQ1, (LAS float*)(F.lds + RING_BYTES)};
    pg8::gemm_phase<EpiOutA, pg8::StaticOrder, true, true>(F.lds, g, S, E);
}

DI void phase_inproj_b(Frame& F) {
    { const int gw = blockIdx.x * NWAVES + F.wave, NGW = F.G * NWAVES;
      for (int task = gw; task < 257 + NTOK / 16; task += NGW) {
          const int rowbase = task <= 256 ? 112 : RB0 + (task - 257) * 16, ntile = task < 256 ? task : 256;
          const f32x4 acc = thin_tile(F.H1 + (size_t)rowbase * DM, F.WB + (size_t)ntile * 16 * DM, F.lane);
          const int row = rowbase + (F.lane & 15), n4 = 4 * (F.lane >> 4);
          const float rs = task <= 256 ? rstd_from16(F.SSQM, 16, F.lane & 15) : rstd_from4(F.SSQ1, NROW, row);
          if (ntile < 256) epiB_quad(acc * rs, row, ntile * 16 + n4, F.PB, F.GG);
          else { const f32x4 bg = *(const f32x4*)(F.b_gates + n4); *(f32x4*)(F.GATES + (size_t)row * 16 + n4) = acc * rs + bg; }
      } }
    pg8::Gemm g{F.H1 + (size_t)RB0 * DM, F.WB, NTOK, B_MAIN, DM}; pg8::StaticOrder S; S.init(NTOK, B_MAIN, F.G, (int)blockIdx.x);
    EpiB E{F.SSQ1, F.PB, F.GG};
    pg8::gemm_phase<EpiB, pg8::StaticOrder, true, true>(F.lds, g, S, E);
}

DI void phase_chunk_naive(Frame& F) {
    LAS bf16* KT = (LAS bf16*)(F.lds);
    LAS bf16* VT = (LAS bf16*)(F.lds + 16384);
    LAS float* SA = (LAS float*)(F.lds + 49152);
    const int tid = F.tid;
    for (int u = blockIdx.x; u < NUNIT; u += F.G) {
        const int bh = u / NCHUNK, n = u % NCHUNK, b = bh >> 3, h = bh & 7, row0 = chunk_row0(b, n);
        for (int c = tid; c < 1024; c += 512) { const int t = c >> 3, ch = c & 7; *(LAS v4u*)(KT + t * 64 + ch * 8) = *(const v4u*)(F.PB + (size_t)(row0 + t) * 2048 + 512 + h * 64 + ch * 8); }
        for (int c = tid; c < 2048; c += 512) { const int t = c >> 4, ch = c & 15; *(LAS v4u*)(VT + t * 128 + ch * 8) = *(const v4u*)(F.PB + (size_t)(row0 + t) * 2048 + 1024 + h * 128 + ch * 8); }
        if (tid < 128) { const bool valid = (n > 0) || (tid >= 112); const float* gp = F.GATES + (size_t)(row0 + tid) * 16;
            SA[tid] = valid ? logsigmoidf_(gp[8 + h]) : 0.f; SA[128 + tid] = valid ? gp[h] : -INFINITY; }
        __syncthreads();
        if (tid == 0) { float bs = 0.f; for (int t = 0; t < 128; ++t) { bs += SA[t]; SA[256 + t] = bs; } SA[512] = bs; }
        __syncthreads();
        const float g = SA[512];
        if (tid < 64) { const float a0 = g - SA[256 + tid] + SA[128 + tid], a1 = g - SA[256 + 64 + tid] + SA[128 + 64 + tid];
            const float ml = wave_max(fmaxf(a0, a1)); SA[384 + tid] = __expf(a0 - ml); SA[384 + 64 + tid] = __expf(a1 - ml); if (tid == 0) SA[513] = ml; }
        __syncthreads();
        { const int v = tid & 127, kg = tid >> 7; float acc[16];
#pragma unroll
          for (int kk = 0; kk < 16; ++kk) acc[kk] = 0.f;
          for (int t = 0; t < 128; ++t) { const float wv = SA[384 + t] * bf2f(VT[t * 128 + v]);
              const v4u k0 = *(const LAS v4u*)(KT + t * 64 + kg * 16), k1 = *(const LAS v4u*)(KT + t * 64 + kg * 16 + 8);
              acc[0] += wv * blo(k0.x); acc[1] += wv * bhi(k0.x); acc[2] += wv * blo(k0.y); acc[3] += wv * bhi(k0.y); acc[4] += wv * blo(k0.z); acc[5] += wv * bhi(k0.z); acc[6] += wv * blo(k0.w); acc[7] += wv * bhi(k0.w);
              acc[8] += wv * blo(k1.x); acc[9] += wv * bhi(k1.x); acc[10] += wv * blo(k1.y); acc[11] += wv * bhi(k1.y); acc[12] += wv * blo(k1.z); acc[13] += wv * bhi(k1.z); acc[14] += wv * blo(k1.w); acc[15] += wv * bhi(k1.w); }
          float* cp = F.CCH + (size_t)u * 8192 + v * 64 + kg * 16;
#pragma unroll
          for (int q = 0; q < 4; ++q) *(f32x4*)(cp + 4 * q) = (f32x4){acc[4 * q], acc[4 * q + 1], acc[4 * q + 2], acc[4 * q + 3]}; }
        if (tid < 64) { float a = 0.f; for (int t = 0; t < 128; ++t) a += SA[384 + t] * bf2f(KT[t * 64 + tid]); F.NCHK[(size_t)u * 64 + tid] = a; }
        if (tid == 0) { F.MLOC[u] = SA[513]; F.GTOT[u] = g; }
        __syncthreads();
    }
}

DI void phase_scan(Frame& F) {
    const int gid = blockIdx.x * (NWAVES * 64) + F.tid, NG = F.G * NWAVES * 64;
    for (int e = gid; e < 16 * 8192 + 16 * 64; e += NG) {
        const bool isn = e >= 16 * 8192; const int ee = isn ? e - 16 * 8192 : e;
        const int bh = isn ? ee >> 6 : ee >> 13, idx = isn ? ee & 63 : ee & 8191;
        const float* src = isn ? F.NCHK + (size_t)bh * NCHUNK * 64 + idx : F.CCH + (size_t)bh * NCHUNK * 8192 + idx; const int sstr = isn ? 64 : 8192;
        float c = 0.f, m = 0.f;
        for (int n0 = 0; n0 < NCHUNK; n0 += 13) {
            float cc[13];
#pragma unroll
            for (int i = 0; i < 13; ++i) cc[i] = src[(size_t)(n0 + i) * sstr];
#pragma unroll
            for (int i = 0; i < 13; ++i) {
                const int u = bh * NCHUNK + n0 + i; const float g = F.GTOT[u], ml = F.MLOC[u];
                if (isn) F.NPREV[(size_t)u * 64 + idx] = c; else { F.CPREV[(size_t)u * 8192 + idx] = (bf16)f2bf(c); if (idx == 0) F.MPREV[u] = m; }
                const float mn = fmaxf(g + m, ml), dec = __expf(g + m - mn), inj = __expf(ml - mn);
                c = dec * c + inj * cc[i]; m = mn;
            }
        }
    }
}

DI void phase_mlstm_out_naive(Frame& F) {
    LAS bf16* QT = (LAS bf16*)(F.lds);
    LAS bf16* KT = (LAS bf16*)(F.lds + 16384);
    LAS bf16* CP = (LAS bf16*)(F.lds + 32768);
    LAS bf16* VT = (LAS bf16*)(F.lds + 49152);
    LAS float* AT = (LAS float*)(F.lds + 81920);
    LAS float* SA = (LAS float*)(F.lds + 147456);
    const int tid = F.tid;
    for (int unit = blockIdx.x; unit < 16 * 64; unit += F.G) {
        const int bh = unit >> 6, n = 1 + (unit & 63), b = bh >> 3, h = bh & 7, u = bh * NCHUNK + n, row0 = chunk_row0(b, n);
        for (int c = tid; c < 1024; c += 512) { const int t = c >> 3, ch = c & 7; const bf16* rp = F.PB + (size_t)(row0 + t) * 2048 + h * 64 + ch * 8;
            *(LAS v4u*)(QT + t * 64 + ch * 8) = *(const v4u*)rp; *(LAS v4u*)(KT + t * 64 + ch * 8) = *(const v4u*)(rp + 512);
            *(LAS v4u*)(CP + c * 8) = *(const v4u*)(F.CPREV + (size_t)u * 8192 + c * 8); }
        for (int c = tid; c < 2048; c += 512) { const int t = c >> 4, ch = c & 15; *(LAS v4u*)(VT + t * 128 + ch * 8) = *(const v4u*)(F.PB + (size_t)(row0 + t) * 2048 + 1024 + h * 128 + ch * 8); }
        if (tid < 128) { const float* gp = F.GATES + (size_t)(row0 + tid) * 16; SA[tid] = logsigmoidf_(gp[8 + h]); SA[128 + tid] = gp[h]; }
        if (tid < 64) SA[896 + tid] = F.NPREV[(size_t)u * 64 + tid];
        __syncthreads();
        if (tid == 0) { const float mp = F.MPREV[u]; float bs = 0.f, pm = -INFINITY;
            for (int t = 0; t < 128; ++t) { bs += SA[t]; const float us = SA[128 + t] - bs; pm = fmaxf(pm, us); const float inter = bs + mp, mt = fmaxf(inter, bs + pm);
                SA[256 + t] = bs; SA[384 + t] = us; SA[512 + t] = mt; SA[640 + t] = __expf(inter - mt); } }
        __syncthreads();
#pragma unroll 1
        for (int i = 0; i < 32; ++i) { const int id = tid + 512 * i, t = id >> 7, s = id & 127; float val = 0.f;
            if (s <= t) { float d = 0.f;
#pragma unroll
                for (int c = 0; c < 8; ++c) d += dot8(*(const LAS v4u*)(QT + t * 64 + c * 8), *(const LAS v4u*)(KT + s * 64 + c * 8));
                val = __expf(SA[256 + t] + SA[384 + s] - SA[512 + t]) * d; }
            AT[t * 128 + s] = val; }
        __syncthreads();
        if (tid < 128) { const int t = tid; float qn = 0.f, rsum = 0.f;
            for (int k = 0; k < 64; ++k) qn += bf2f(QT[t * 64 + k]) * SA[896 + k];
            for (int s = 0; s <= t; ++s) rsum += AT[t * 128 + s];
            SA[768 + t] = SA[640 + t] * qn + rsum; }
        __syncthreads();
        { const int v = tid & 127, tg = tid >> 7;
#pragma unroll 1
          for (int t = tg * 32; t < tg * 32 + 32; ++t) {
              float acc = 0.f;
#pragma unroll
              for (int c = 0; c < 8; ++c) acc += dot8(*(const LAS v4u*)(QT + t * 64 + c * 8), *(const LAS v4u*)(CP + v * 64 + c * 8));
              acc *= SA[640 + t];
              for (int s = 0; s <= t; ++s) acc += AT[t * 128 + s] * bf2f(VT[s * 128 + v]);
              const float hc = acc / fmaxf(fabsf(SA[768 + t]), __expf(-SA[512 + t]));
              const size_t oi = (size_t)(row0 + t) * DM + h * 128 + v;
              F.YB[oi] = (bf16)f2bf(hc * bf2f(F.GG[oi]));
          } }
        __syncthreads();
    }
}

DI float scan_add64(float x, int lane) {
#pragma unroll
    for (int d = 1; d < 64; d <<= 1) { const float y = __shfl_up(x, d); if (lane >= d) x += y; }
    return x;
}
DI float scan_max64(float x, int lane) {
#pragma unroll
    for (int d = 1; d < 64; d <<= 1) { const float y = __shfl_up(x, d); if (lane >= d) x = fmaxf(x, y); }
    return x;
}
constexpr float LOG2E = 1.4426950408889634f;
DI void phase_chunk(Frame& F) {
    LAS unsigned char* VI = F.lds;
    LAS unsigned char* KI = F.lds + 32768;
    LAS float* WL = (LAS float*)(F.lds + 49152);
    LAS float* PART = (LAS float*)(F.lds + 49152 + 512);
    const int tid = F.tid, lane = F.lane, r32 = lane & 31, hi = lane >> 5, wave = F.wave;
    const int vlane = ((lane & 15) >> 2) * 64 + ((lane >> 4) & 1) * 32 + (lane & 3) * 8 + hi * 256;
    for (int u = blockIdx.x; u < NUNIT; u += F.G) {
        const int bh = u / NCHUNK, n = u % NCHUNK, b = bh >> 3, h = bh & 7, row0 = chunk_row0(b, n);
        if (wave == 0) {
            const bool v0 = (n > 0) || (lane >= 112), v1 = (n > 0) || (lane + 64 >= 112);
            const float* g0 = F.GATES + (size_t)(row0 + lane) * 16; const float* g1 = g0 + 64 * 16;
            const float lf0 = v0 ? logsigmoidf_(g0[8 + h]) : 0.f, lf1 = v1 ? logsigmoidf_(g1[8 + h]) : 0.f;
            const float il0 = v0 ? g0[h] : -INFINITY, il1 = v1 ? g1[h] : -INFINITY;
            const float b0 = scan_add64(lf0, lane), tot0 = __shfl(b0, 63), b1 = tot0 + scan_add64(lf1, lane), g = __shfl(b1, 63);
            const float a0 = g - b0 + il0, a1 = g - b1 + il1, ml = wave_max(fmaxf(a0, a1));
            WL[lane] = __expf(a0 - ml); WL[lane + 64] = __expf(a1 - ml);
            if (lane == 0) { F.MLOC[u] = ml; F.GTOT[u] = g; }
        }
        __syncthreads();
        for (int c = tid; c < 1024; c += 512) { const int t = c >> 3, ch = c & 7; const bool valid = (n > 0) || (t >= 112); const float w = WL[t];
            v4u kv = *(const v4u*)(F.PB + (size_t)(row0 + t) * 2048 + 512 + h * 64 + ch * 8);
            v4u o; o.x = pg8::cvt_pk_bf16(blo(kv.x) * w, bhi(kv.x) * w); o.y = pg8::cvt_pk_bf16(blo(kv.y) * w, bhi(kv.y) * w); o.z = pg8::cvt_pk_bf16(blo(kv.z) * w, bhi(kv.z) * w); o.w = pg8::cvt_pk_bf16(blo(kv.w) * w, bhi(kv.w) * w);
            if (!valid) o = (v4u){0u, 0u, 0u, 0u};
            *(LAS v4u*)(KI + (ch >> 2) * 8192 + t * 64 + (ch & 3) * 16) = o; }
        for (int c = tid; c < 2048; c += 512) { const int t = c >> 4, ch = c & 15; const bool valid = (n > 0) || (t >= 112);
            v4u vv = *(const v4u*)(F.PB + (size_t)(row0 + t) * 2048 + 1024 + h * 128 + ch * 8); if (!valid) vv = (v4u){0u, 0u, 0u, 0u};
            *(LAS v4u*)(VI + (ch >> 2) * 8192 + t * 64 + (ch & 3) * 16) = vv; }
        __syncthreads();
        { const int vt = wave >> 1, kt = wave & 1;
          f32x16 acc = {0.f, 0.f, 0.f, 0.f, 0.f, 0.f, 0.f, 0.f, 0.f, 0.f, 0.f, 0.f, 0.f, 0.f, 0.f, 0.f};
#pragma unroll
          for (int s = 0; s < 8; ++s) {
              const LAS unsigned char* ap = VI + vt * 8192 + (16 * s) * 64 + vlane; const LAS unsigned char* bp = KI + kt * 8192 + (16 * s) * 64 + vlane;
              acc = __builtin_amdgcn_mfma_f32_32x32x16_bf16(cat8(lds_tr(ap), lds_tr(ap + 512)), cat8(lds_tr(bp), lds_tr(bp + 512)), acc, 0, 0, 0);
          }
          float* cp = F.CCH + (size_t)u * 8192 + (32 * vt) * 64 + 32 * kt + r32;
#pragma unroll
          for (int r = 0; r < 16; ++r) cp[crow(r, hi) * 64] = acc[r]; }
        { float a = 0.f; const LAS bf16* kp = (const LAS bf16*)(KI + (lane >> 5) * 8192) + (lane & 31);
#pragma unroll
          for (int t = 0; t < 16; ++t) a += bf2f(kp[(16 * wave + t) * 32]);
          PART[wave * 64 + lane] = a; }
        __syncthreads();
        if (wave == 0) { float a = 0.f;
#pragma unroll
            for (int w = 0; w < 8; ++w) a += PART[w * 64 + lane];
            F.NCHK[(size_t)u * 64 + lane] = a; }
        __syncthreads();
    }
}
DI void phase_mlstm_out(Frame& F) {
    const int tid = F.tid, lane = F.lane, r32 = lane & 31, hi = lane >> 5, wave = F.wave, hs = wave >> 2, w4 = wave & 3, t256 = tid & 255;
    LAS unsigned char* KL = F.lds + hs * 49152;
    LAS unsigned char* VI = F.lds + hs * 49152 + 16384;
    LAS float* SM = (LAS float*)(F.lds + 98304 + hs * 4096);
    LAS unsigned char* OST = F.lds + 106496 + wave * 4096;
    const int vlane = ((lane & 15) >> 2) * 64 + ((lane >> 4) & 1) * 32 + (lane & 3) * 8 + hi * 256;
    const int i = hs == 0 ? w4 : 3 - w4;
    for (int pair = blockIdx.x; pair < 512; pair += F.G) {
        const int unit = 2 * pair + hs, bh = unit >> 6, n = 1 + (unit & 63), b = bh >> 3, h = bh & 7, u = bh * NCHUNK + n, row0 = chunk_row0(b, n);
        if (w4 == 0) {
            const float* g0 = F.GATES + (size_t)(row0 + lane) * 16; const float* g1 = g0 + 64 * 16;
            const float lf0 = logsigmoidf_(g0[8 + h]), lf1 = logsigmoidf_(g1[8 + h]), il0 = g0[h], il1 = g1[h];
            const float b0 = scan_add64(lf0, lane), tot0 = __shfl(b0, 63), b1 = tot0 + scan_add64(lf1, lane);
            const float us0 = il0 - b0, us1 = il1 - b1;
            const float pm0 = scan_max64(us0, lane), pmt = __shfl(pm0, 63), pm1 = fmaxf(pmt, scan_max64(us1, lane));
            const float mp = F.MPREV[u];
            const float in0 = b0 + mp, in1 = b1 + mp, mt0 = fmaxf(in0, b0 + pm0), mt1 = fmaxf(in1, b1 + pm1);
            SM[lane] = b0 - mt0; SM[64 + lane] = b1 - mt1; SM[128 + lane] = us0; SM[192 + lane] = us1;
            SM[256 + lane] = __expf(in0 - mt0); SM[320 + lane] = __expf(in1 - mt1); SM[384 + lane] = __expf(-mt0); SM[448 + lane] = __expf(-mt1);
            SM[512 + lane] = F.NPREV[(size_t)u * 64 + lane];
        }
        for (int c = t256; c < 1024; c += 256) { const int t = c >> 3, ch = c & 7;
            *(LAS v4u*)(KL + t * 128 + ((ch ^ ((t >> 1) & 7)) << 4)) = *(const v4u*)(F.PB + (size_t)(row0 + t) * 2048 + 512 + h * 64 + ch * 8); }
        for (int c = t256; c < 2048; c += 256) { const int t = c >> 4, ch = c & 15;
            *(LAS v4u*)(VI + (ch >> 2) * 8192 + t * 64 + (ch & 3) * 16) = *(const v4u*)(F.PB + (size_t)(row0 + t) * 2048 + 1024 + h * 128 + ch * 8); }
        bf16x8 qf[4];
        { const bf16* qp = F.PB + (size_t)(row0 + 32 * i + r32) * 2048 + h * 64 + 8 * hi;
#pragma unroll
          for (int ks = 0; ks < 4; ++ks) qf[ks] = *(const bf16x8*)(qp + 16 * ks); }
        f32x16 acc[4];
        { const bf16* cpp = F.CPREV + (size_t)u * 8192 + (size_t)r32 * 64 + 8 * hi;
#pragma unroll
          for (int vt = 0; vt < 4; ++vt) { f32x16 a = {0.f, 0.f, 0.f, 0.f, 0.f, 0.f, 0.f, 0.f, 0.f, 0.f, 0.f, 0.f, 0.f, 0.f, 0.f, 0.f};
#pragma unroll
              for (int ks = 0; ks < 4; ++ks) a = __builtin_amdgcn_mfma_f32_32x32x16_bf16(qf[ks], *(const bf16x8*)(cpp + vt * 32 * 64 + 16 * ks), a, 0, 0, 0);
              acc[vt] = a; } }
        __syncthreads();
        { const LAS float* iwp = SM + 256 + 32 * i + 4 * hi;
#pragma unroll
          for (int q4 = 0; q4 < 4; ++q4) { const f32x4 w = *(const LAS f32x4*)(iwp + 8 * q4);
#pragma unroll
              for (int e = 0; e < 4; ++e) { acc[0][4 * q4 + e] *= w[e]; acc[1][4 * q4 + e] *= w[e]; acc[2][4 * q4 + e] *= w[e]; acc[3][4 * q4 + e] *= w[e]; } } }
        float qn = 0.f;
#pragma unroll
        for (int ks = 0; ks < 4; ++ks) { const v4u qw = __builtin_bit_cast(v4u, qf[ks]); const f32x4 n0 = *(const LAS f32x4*)(SM + 512 + 16 * ks + 8 * hi), n1 = *(const LAS f32x4*)(SM + 512 + 16 * ks + 8 * hi + 4);
            qn += blo(qw.x) * n0[0] + bhi(qw.x) * n0[1] + blo(qw.y) * n0[2] + bhi(qw.y) * n0[3] + blo(qw.z) * n1[0] + bhi(qw.z) * n1[1] + blo(qw.w) * n1[2] + bhi(qw.w) * n1[3]; }
        qn += __shfl_xor(qn, 32);
        const float bcol = SM[32 * i + r32] * LOG2E; float dsum = 0.f;
#pragma unroll 1
        for (int j = 0; j <= i; ++j) {
            const int key = 32 * j + r32; const LAS unsigned char* kp = KL + key * 128; const int sw = (key >> 1) & 7;
            f32x16 st = {0.f, 0.f, 0.f, 0.f, 0.f, 0.f, 0.f, 0.f, 0.f, 0.f, 0.f, 0.f, 0.f, 0.f, 0.f, 0.f};
#pragma unroll
            for (int ks = 0; ks < 4; ++ks) st = __builtin_amdgcn_mfma_f32_32x32x16_bf16(*(const LAS bf16x8*)(kp + (((2 * ks + hi) ^ sw) << 4)), qf[ks], st, 0, 0, 0);
            const LAS float* usp = SM + 128 + 32 * j + 4 * hi;
#pragma unroll
            for (int q4 = 0; q4 < 4; ++q4) { const f32x4 us = *(const LAS f32x4*)(usp + 8 * q4);
#pragma unroll
                for (int e = 0; e < 4; ++e) { const int r = 4 * q4 + e; float wv = __builtin_amdgcn_exp2f(us[e] * LOG2E + bcol) * st[r];
                    if (j == i && crow(r, hi) > r32) wv = 0.f;
                    st[r] = wv; dsum += wv; } }
#pragma unroll
            for (int s2 = 0; s2 < 2; ++s2) {
                const bf16x8 pa = pack8(st[8 * s2], st[8 * s2 + 1], st[8 * s2 + 2], st[8 * s2 + 3], st[8 * s2 + 4], st[8 * s2 + 5], st[8 * s2 + 6], st[8 * s2 + 7]);
                const LAS unsigned char* vp = VI + (32 * j + 16 * s2) * 64 + vlane;
#pragma unroll
                for (int vt = 0; vt < 4; ++vt) acc[vt] = __builtin_amdgcn_mfma_f32_32x32x16_bf16(pa, cat8(lds_tr(vp + vt * 8192), lds_tr(vp + vt * 8192 + 512)), acc[vt], 0, 0, 0);
            }
        }
        dsum += __shfl_xor(dsum, 32);
        { const float den = SM[256 + 32 * i + r32] * qn + dsum; const float dd = 1.0f / fmaxf(fabsf(den), SM[384 + 32 * i + r32]);
          if (hi == 0) SM[576 + w4 * 32 + r32] = dd; }
        LDS_WAIT(); asm volatile("" ::: "memory");
        { const LAS float* ddp = SM + 576 + w4 * 32 + 4 * hi;
#pragma unroll
          for (int q4 = 0; q4 < 4; ++q4) { const f32x4 w = *(const LAS f32x4*)(ddp + 8 * q4);
#pragma unroll
              for (int e = 0; e < 4; ++e) { acc[0][4 * q4 + e] *= w[e]; acc[1][4 * q4 + e] *= w[e]; acc[2][4 * q4 + e] *= w[e]; acc[3][4 * q4 + e] *= w[e]; } } }
#pragma unroll
        for (int half = 0; half < 2; ++half) {
#pragma unroll
            for (int r = 0; r < 16; ++r) { LAS bf16* sp = (LAS bf16*)(OST + crow(r, hi) * 128) + r32; sp[0] = (bf16)f2bf(acc[2 * half][r]); sp[32] = (bf16)f2bf(acc[2 * half + 1][r]); }
            LDS_WAIT(); asm volatile("" ::: "memory");
#pragma unroll
            for (int it = 0; it < 4; ++it) {
                const int row = it * 8 + (lane >> 3), ch = lane & 7; const v4u ov = *(const LAS v4u*)(OST + row * 128 + ch * 16);
                const size_t gi = (size_t)(row0 + 32 * i + row) * DM + h * 128 + half * 64 + ch * 8; const v4u gv = *(const v4u*)(F.GG + gi);
                v4u w; w.x = pg8::cvt_pk_bf16(blo(ov.x) * blo(gv.x), bhi(ov.x) * bhi(gv.x)); w.y = pg8::cvt_pk_bf16(blo(ov.y) * blo(gv.y), bhi(ov.y) * bhi(gv.y));
                w.z = pg8::cvt_pk_bf16(blo(ov.z) * blo(gv.z), bhi(ov.z) * bhi(gv.z)); w.w = pg8::cvt_pk_bf16(blo(ov.w) * blo(gv.w), bhi(ov.w) * bhi(gv.w));
                *(v4u*)(F.YB + gi) = w;
            }
            LDS_WAIT(); asm volatile("" ::: "memory");
        }
        __syncthreads();
    }
}

DI void phase_outproj_b(Frame& F) {
    pg8::Gemm g{F.YB + (size_t)RB0 * DM, F.WOB, NTOK, DM, DM}; pg8::StaticOrder S; S.init(NTOK, DM, F.G, (int)blockIdx.x);
    EpiOutB E{F.H1, F.out, F.SSQ2, (LAS float*)(F.lds + RING_BYTES)};
    pg8::gemm_phase<EpiOutB, pg8::StaticOrder, true, true>(F.lds, g, S, E);
}
DI void phase_final_norm(Frame& F) {
    const int gw = blockIdx.x * NWAVES + F.wave, NGW = F.G * NWAVES;
    f32x4 gn[4];
#pragma unroll
    for (int j = 0; j < 4; ++j) gn[j] = ((const f32x4*)F.norm_f)[F.lane + 64 * j];
    for (int m = gw; m < NTOK; m += NGW) {
        const float rs = rstd_from4(F.SSQ2, NTOK, m);
        GAS f32x4* o = (GAS f32x4*)(F.out + (size_t)m * DM) + F.lane;
#pragma unroll
        for (int j = 0; j < 4; ++j) o[64 * j] = o[64 * j] * rs * gn[j];
    }
}
#define XB_TMO      128
#define XB_XCNT(j)  (256  + 64 * (j))
#define XB_XSUB(j)  (1280 + 64 * (j))
#define XB_XGEN(j)  (2304 + 64 * (j))
#define XB_TOP      3328
#define XB_TOPGEN   3392
#define XCD_BAR_WORDS 3456
#define XB_SPIN_CAP (1u << 18)

__device__ __forceinline__ unsigned xb_ld(unsigned* p)              { return __hip_atomic_load(p, __ATOMIC_RELAXED, __HIP_MEMORY_SCOPE_AGENT); }
__device__ __forceinline__ unsigned xb_add(unsigned* p, unsigned v) { return __hip_atomic_fetch_add(p, v, __ATOMIC_RELAXED, __HIP_MEMORY_SCOPE_AGENT); }
__device__ __forceinline__ unsigned xb_xcc_id() { return (unsigned)__builtin_amdgcn_s_getreg((3 << 11) | 20) & 0xFu; }
#define XB_SPIN(cond, bar) do { unsigned _sp = 0; while (cond) { __builtin_amdgcn_s_sleep(1); \
    if ((++_sp & 255u) == 0u) { if (xb_ld(&(bar)[XB_TMO])) break; if (_sp > XB_SPIN_CAP) { atomicAdd(&(bar)[XB_TMO], 1u); break; } } } } while (0)

struct XcdBarrier {
    unsigned* bar; unsigned x;
    volatile LAS unsigned* st;
};

__device__ __forceinline__ XcdBarrier xcd_barrier_post(unsigned* bar, volatile LAS unsigned* st) {
    XcdBarrier b; b.bar = bar; b.x = xb_xcc_id(); b.st = st;
    if (threadIdx.x == 0) (void)xb_add(&bar[XB_XCNT(b.x)], 1u);
    return b;
}
__device__ __forceinline__ void xcd_barrier_complete(unsigned* bar, unsigned x, unsigned& nloc, unsigned& nx) {
    const unsigned G = gridDim.x * gridDim.y * gridDim.z;
    unsigned sum, cnt, mine, sp = 0u;
    for (;;) {
        sum = 0u; cnt = 0u; mine = 0u;
#pragma unroll
        for (unsigned j = 0; j < 16; ++j) { const unsigned c = xb_ld(&bar[XB_XCNT(j)]); sum += c; cnt += (c > 0u) ? 1u : 0u; mine = (j == x) ? c : mine; }
        if (sum == G) break;
        __builtin_amdgcn_s_sleep(1);
        if ((++sp & 255u) == 0u) { if (xb_ld(&bar[XB_TMO])) break; if (sp > XB_SPIN_CAP) { atomicAdd(&bar[XB_TMO], 1u); break; } }
    }
    nloc = mine > 0u ? mine : 1u; nx = cnt > 0u ? cnt : 1u;
}

__device__ __forceinline__ void xcd_barrier(const XcdBarrier& b) {
    asm volatile("s_waitcnt vmcnt(0)" ::: "memory");
    __syncthreads();
    if (threadIdx.x == 0) {
        unsigned* bar = b.bar;
        __builtin_amdgcn_s_waitcnt(0);
        unsigned nloc = b.st[0], nx = b.st[1];
        if (nloc == 0u) { xcd_barrier_complete(bar, b.x, nloc, nx); b.st[0] = nloc; b.st[1] = nx; }
        const unsigned old = xb_add(&bar[XB_XSUB(b.x)], 1u);
        const unsigned gen = old / nloc;
        if (old + 1u == (gen + 1u) * nloc) {
            __builtin_amdgcn_fence(__ATOMIC_RELEASE, "agent");
            asm volatile("s_waitcnt vmcnt(0)" ::: "memory");
            const unsigned og = xb_add(&bar[XB_TOP], 1u);
            const unsigned tg = og / nx;
            if (og + 1u == (tg + 1u) * nx) xb_add(&bar[XB_TOPGEN], 1u);
            else XB_SPIN(xb_ld(&bar[XB_TOPGEN]) == tg, bar);
            __builtin_amdgcn_fence(__ATOMIC_ACQUIRE, "agent");
            xb_add(&bar[XB_XGEN(b.x)], 1u);
            asm volatile("s_waitcnt vmcnt(0)" ::: "memory");
        } else {
            XB_SPIN(xb_ld(&bar[XB_XGEN(b.x)]) == gen, bar);
            __builtin_amdgcn_fence(__ATOMIC_ACQUIRE, "agent");
            asm volatile("s_waitcnt vmcnt(0)" ::: "memory");
        }
    }
    __syncthreads();
}

#ifndef USE_NAIVE_ATTN
#define USE_NAIVE_ATTN 0
#endif
#ifndef USE_NAIVE_CHUNK
#define USE_NAIVE_CHUNK 0
#endif
#ifndef USE_NAIVE_MOUT
#define USE_NAIVE_MOUT 0
#endif
#ifndef PHASE_MASK
#define PHASE_MASK 0x3ff
#endif
struct Args { const float* in[11]; float* out; unsigned char* ws; int ph_lo, ph_hi; };
__global__ void __launch_bounds__(NWAVES * 64, 2) fwd_kernel(Args args) {
    extern __shared__ __attribute__((aligned(16))) unsigned char lds[];
    Frame F;
    F.lds = (LAS unsigned char*)lds;
    F.MISC = (volatile LAS unsigned*)(F.lds + MISC_OFF);
    F.tid = threadIdx.x; F.lane = F.tid & 63; F.wave = __builtin_amdgcn_readfirstlane(F.tid >> 6);
    F.G = gridDim.x;
    unsigned char* ws = args.ws;
    F.ctl = (gu32*)(ws + WS_CTL);
    F.x = args.in[0]; F.meta = args.in[1]; F.norm_a = args.in[2]; F.w_in_a = args.in[3]; F.sinks = args.in[4]; F.w_out_a = args.in[5];
    F.norm_b = args.in[6]; F.w_in_b = args.in[7]; F.b_gates = args.in[8]; F.w_out_b = args.in[9]; F.norm_f = args.in[10]; F.out = args.out;
    F.WA = (bf16*)(ws + WS_WA); F.WOA = (bf16*)(ws + WS_WOA); F.WB = (bf16*)(ws + WS_WB); F.WOB = (bf16*)(ws + WS_WOB);
    F.RSTD0 = (float*)(ws + WS_RSTD0); F.SSQ1 = (float*)(ws + WS_SSQ1); F.SSQM = (float*)(ws + WS_SSQ1 + MiB); F.GATES = (float*)(ws + WS_GATES); F.SSQ2 = (float*)(ws + WS_SSQ2);
    F.NCHK = (float*)(ws + WS_STAT + ST_NCHK); F.MLOC = (float*)(ws + WS_STAT + ST_MLOC); F.GTOT = (float*)(ws + WS_STAT + ST_GTOT);
    F.MPREV = (float*)(ws + WS_STAT + ST_MPREV); F.NPREV = (float*)(ws + WS_STAT + ST_NPREV);
    F.XB = (bf16*)(ws + WS_RA); F.YA = F.XB; F.YB = F.XB; F.Q = (bf16*)(ws + WS_RB); F.H1 = F.Q; F.SZ = (bf16*)(ws + WS_RC);
    F.K = (bf16*)(ws + WS_K); F.V = (bf16*)(ws + WS_V); F.PB = (bf16*)(ws + WS_PB); F.GG = (bf16*)(ws + WS_G);
    F.CCH = (float*)((unsigned char*)args.out + OUT_CCH); F.CPREV = (bf16*)((unsigned char*)args.out + OUT_CPREV);
    for (int u = F.tid; u < (LDS_BYTES - LDSCTL_OFF) / 4; u += NWAVES * 64) ((LAS unsigned*)(F.lds + LDSCTL_OFF))[u] = 0u;
    __syncthreads();
    XcdBarrier bar; bar.bar = (unsigned*)(F.ctl + CW_BAR); bar.x = 0; bar.st = nullptr;
    if (N_LAUNCHES == 1) bar = xcd_barrier_post((unsigned*)(F.ctl + CW_BAR), F.MISC + 8);
#define GRID_BAR() do { if (N_LAUNCHES == 1) xcd_barrier(bar); } while (0)
    const int lo = args.ph_lo, hi = args.ph_hi;
#define IN(k) (lo <= (k) && (k) < hi)
#define BOTH(k) (IN(k) && IN((k) + 1))
    if (((PHASE_MASK >> 0) & 1) && IN(0)) { p0_prologue(F); if (BOTH(0)) GRID_BAR(); }
    if (((PHASE_MASK >> 1) & 1) && IN(1)) { phase_inproj_a(F); if (BOTH(1)) GRID_BAR(); }
    if (((PHASE_MASK >> 2) & 1) && IN(2)) { if (USE_NAIVE_ATTN) phase_attn_naive(F); else phase_attn(F); if (BOTH(2)) GRID_BAR(); }
    if (((PHASE_MASK >> 3) & 1) && IN(3)) { phase_outproj_a(F); if (BOTH(3)) GRID_BAR(); }
    if (((PHASE_MASK >> 4) & 1) && IN(4)) { phase_inproj_b(F); if (BOTH(4)) GRID_BAR(); }
    if (((PHASE_MASK >> 5) & 1) && IN(5)) { if (USE_NAIVE_CHUNK) phase_chunk_naive(F); else phase_chunk(F); if (BOTH(5)) GRID_BAR(); }
    if (((PHASE_MASK >> 6) & 1) && IN(6)) { phase_scan(F); if (BOTH(6)) GRID_BAR(); }
    if (((PHASE_MASK >> 7) & 1) && IN(7)) { if (USE_NAIVE_MOUT) phase_mlstm_out_naive(F); else phase_mlstm_out(F); if (BOTH(7)) GRID_BAR(); }
    if (((PHASE_MASK >> 8) & 1) && IN(8)) { phase_outproj_b(F); if (BOTH(8)) GRID_BAR(); }
    if (((PHASE_MASK >> 9) & 1) && IN(9)) { phase_final_norm(F); }
#undef IN
#undef BOTH
}

extern "C" void kernel_launch(void* const* d_in, const int* in_sizes, int n_in, void* d_out, int out_size, void* d_ws, size_t ws_size, hipStream_t stream) {
    static int grid = 0;
    if (grid == 0) {
        if (n_in != 11 || in_sizes[0] != NTOK * DM || out_size != NTOK * DM || ws_size < WS_END) { fprintf(stderr, "kernel_launch: unexpected shapes (n_in %d, in0 %d, out %d, ws %zu); nothing launched\n", n_in, n_in > 0 ? in_sizes[0] : -1, out_size, ws_size); grid = -1; return; }
        int dev = 0, cus = 0, per_cu = 0;
        if (hipGetDevice(&dev) != hipSuccess || hipDeviceGetAttribute(&cus, hipDeviceAttributeMultiprocessorCount, dev) != hipSuccess) { fprintf(stderr, "kernel_launch: device query failed\n"); grid = -1; return; }
        if (hipFuncSetAttribute((const void*)fwd_kernel, hipFuncAttributeMaxDynamicSharedMemorySize, LDS_BYTES) != hipSuccess) { fprintf(stderr, "kernel_launch: hipFuncSetAttribute failed\n"); grid = -1; return; }
        if (hipOccupancyMaxActiveBlocksPerMultiprocessor(&per_cu, (const void*)fwd_kernel, NWAVES * 64, LDS_BYTES) != hipSuccess || per_cu < 1) { fprintf(stderr, "kernel_launch: occupancy query reports %d workgroups per CU\n", per_cu); per_cu = 1; }
        (void)hipGetLastError();
        grid = cus;
        if (grid != 256) fprintf(stderr, "kernel_launch: %d CUs (expected 256)\n", grid);
    }
    if (grid < 0) return;
    (void)hipMemsetAsync((char*)d_ws + WS_CTL, 0, CTL_ZERO_BYTES, stream);
    Args a{};
    for (int i = 0; i < 11; ++i) a.in[i] = (const float*)d_in[i];
    a.out = (float*)d_out; a.ws = (unsigned char*)d_ws;
    if (N_LAUNCHES == 1) { a.ph_lo = 0; a.ph_hi = NPHASE; hipLaunchKernelGGL(fwd_kernel, dim3(grid), dim3(NWAVES * 64), LDS_BYTES, stream, a); }
    else for (int p = 0; p < NPHASE; ++p) { a.ph_lo = p; a.ph_hi = p + 1; hipLaunchKernelGGL(fwd_kernel, dim3(grid), dim3(NWAVES * 64), LDS_BYTES, stream, a); }
}
```
